# Optimizing an MI355X kernel written in HIP

```python
import jax, jax.numpy as jnp
from jax import lax
import numpy as np


D_MODEL = 2048
BATCH = 8
SEQ = 4096
DEPTH = 2

D_MIX = D_MODEL
ATT_GROUPS = ((128, 1), (512, 4), (2048, 16))
N_ATT_GROUPS = len(ATT_GROUPS)
ATT_WIDTH = D_MIX // 4
ATT_HEAD_DIM = 64
ATT_HEADS = ATT_WIDTH // ATT_HEAD_DIM
ATT_QKV = N_ATT_GROUPS * ATT_WIDTH
ROT_DIM = ATT_HEAD_DIM // 4
ROPE_THETA = 500000.0
ATT_BLOCK = 128
SGU_WIDTH = D_MIX // 4
SGU_GROUPS = 4
SGU_GROUP_DIM = SGU_WIDTH // SGU_GROUPS
SGU_CHUNK = 128
MLSTM_WIDTH = D_MIX - ATT_WIDTH - SGU_WIDTH
MLSTM_HEADS = 4
MLSTM_HEAD_DIM = MLSTM_WIDTH // MLSTM_HEADS
MLSTM_CHUNK = 128
CONV_WIDTH = 4
LN_EPS = 1e-5

SPLIT_SIZES = (
    ATT_QKV, ATT_QKV, ATT_QKV, ATT_WIDTH,
    SGU_WIDTH, SGU_WIDTH, SGU_WIDTH,
    MLSTM_WIDTH, MLSTM_WIDTH, MLSTM_WIDTH,
    MLSTM_WIDTH, MLSTM_WIDTH,
    MLSTM_HEADS, MLSTM_HEADS,
)
D_IN = sum(SPLIT_SIZES)

kernel_name = 'hybrid_dilated_attn_sgu_mlstm_deepnorm'

F32 = jnp.float32


def split_columns(z):
    idx, acc = [], 0
    for s in SPLIT_SIZES[:-1]:
        acc += s
        idx.append(acc)
    return jnp.split(z, idx, axis=-1)


def layer_norm(x, g, b):
    xf = x.astype(F32)
    mu = xf.mean(-1, keepdims=True)
    var = jnp.square(xf - mu).mean(-1, keepdims=True)
    return ((xf - mu) * lax.rsqrt(var + LN_EPS) * g + b).astype(x.dtype)


def head_norm(h, g):
    B, S, _ = h.shape
    hh = h.reshape(B, S, MLSTM_HEADS, MLSTM_HEAD_DIM)
    mu = hh.mean(-1, keepdims=True)
    var = jnp.square(hh - mu).mean(-1, keepdims=True)
    return ((hh - mu) * lax.rsqrt(var + LN_EPS)).reshape(B, S, MLSTM_WIDTH) * g


def rope_tables(positions):
    half = ROT_DIM // 2
    inv_freq = ROPE_THETA ** (-jnp.arange(half, dtype=F32) * 2.0 / ROT_DIM)
    ang = positions.astype(F32)[..., None] * inv_freq
    return jnp.cos(ang)[:, :, None, :], jnp.sin(ang)[:, :, None, :]


def apply_partial_rope(t, cos, sin):
    half = ROT_DIM // 2
    tr = t[..., :ROT_DIM].astype(F32)
    t1, t2 = tr[..., :half], tr[..., half:]
    rot = jnp.concatenate([t1 * cos - t2 * sin, t2 * cos + t1 * sin], axis=-1)
    return jnp.concatenate([rot.astype(t.dtype), t[..., ROT_DIM:]], axis=-1)


def dilated_window_attention(q, k, v, window, dilation):
    B, S, H, hd = q.shape
    reach = window // dilation
    L = S // dilation
    nb = -(-L // ATT_BLOCK)
    Lp = nb * ATT_BLOCK

    def to_sub(t):
        t = t.astype(F32).reshape(B, L, dilation, H, hd).transpose(0, 2, 3, 1, 4)
        t = jnp.pad(t, ((0, 0), (0, 0), (0, 0), (0, Lp - L), (0, 0)))
        return t.reshape(B, dilation, H, nb, ATT_BLOCK, hd)

    def with_prev(t):
        prev = jnp.pad(t, ((0, 0), (0, 0), (0, 0), (1, 0), (0, 0), (0, 0)))[:, :, :, :-1]
        return jnp.concatenate([prev, t], axis=4)

    qb, kb, vb = to_sub(q), to_sub(k), to_sub(v)
    kw, vw = with_prev(kb), with_prev(vb)
    s = jnp.einsum('bdhnqc,bdhnkc->bdhnqk', qb, kw) * (hd ** -0.5)
    qi = jnp.arange(ATT_BLOCK)[:, None] + ATT_BLOCK
    ki = jnp.arange(2 * ATT_BLOCK)[None, :]
    dist = qi - ki
    band = (dist >= 0) & (dist <= reach)
    blk_ids = jnp.arange(nb)[:, None, None]
    valid = band[None] & ((blk_ids > 0) | (ki >= ATT_BLOCK)[None])
    s = jnp.where(valid, s, -jnp.inf)
    m = s.max(-1, keepdims=True)
    p = jnp.exp(s - m)
    l = p.sum(-1, keepdims=True)
    o = jnp.einsum('bdhnqk,bdhnkc->bdhnqc', p, vw) / l
    lse = (m + jnp.log(l))[..., 0]
    o = o.reshape(B, dilation, H, Lp, hd)[:, :, :, :L].transpose(0, 3, 1, 2, 4).reshape(B, S, H, hd)
    lse = lse.reshape(B, dilation, H, Lp)[..., :L].transpose(0, 3, 1, 2).reshape(B, S, H)
    return o, lse


def spatial_gating(u, v, ln_g, ln_b, w_s, b_s):
    B, S, _ = v.shape
    v = layer_norm(v, ln_g, ln_b)
    nc = S // SGU_CHUNK
    vc = v.reshape(B, nc, SGU_CHUNK, SGU_GROUPS, SGU_GROUP_DIM)
    w = w_s * jnp.tril(jnp.ones((SGU_CHUNK, SGU_CHUNK), dtype=w_s.dtype))
    mixed = jnp.einsum('gts,bcsgk->bctgk', w, vc) + b_s.T[None, None, :, :, None]
    return u * mixed.reshape(B, S, SGU_WIDTH)


def causal_depthwise_conv(x, w, b):
    y = lax.conv_general_dilated(
        x, w[:, None, :], window_strides=(1,), padding=[(CONV_WIDTH - 1, 0)],
        dimension_numbers=('NWC', 'WIO', 'NWC'), feature_group_count=x.shape[-1])
    return y + b


def mlstm_chunkwise(q, k, v, ig, lf):
    B, H, S, d = q.shape
    L = MLSTM_CHUNK
    nc = S // L

    def chunks(t):
        return jnp.moveaxis(t.reshape(B, H, nc, L, *t.shape[3:]), 2, 0)

    xs = (chunks(q), chunks(k), chunks(v), chunks(ig), chunks(lf))
    causal = jnp.tril(jnp.ones((L, L), dtype=bool))

    def step(carry, inp):
        C, n, m = carry
        qc, kc, vc, ic, fc = inp
        b = jnp.cumsum(fc, axis=-1)
        g = b[..., -1]
        D = jnp.where(causal, b[..., :, None] - b[..., None, :] + ic[..., None, :], -jnp.inf)
        m_inter = b + m[..., None]
        m_t = jnp.maximum(D.max(-1), m_inter)
        inter = jnp.exp(m_inter - m_t)
        sc = jnp.einsum('bhtd,bhsd->bhts', qc, kc) * jnp.exp(D - m_t[..., None])
        num = jnp.einsum('bhts,bhsd->bhtd', sc, vc) + inter[..., None] * jnp.einsum('bhtk,bhkv->bhtv', qc, C)
        den = sc.sum(-1) + inter * jnp.einsum('bhtk,bhk->bht', qc, n)
        h = num / jnp.maximum(jnp.abs(den), jnp.exp(-m_t))[..., None]
        a = g[..., None] - b + ic
        m_new = jnp.maximum(g + m, a.max(-1))
        decay = jnp.exp(g + m - m_new)
        wts = jnp.exp(a - m_new[..., None])
        C = decay[..., None, None] * C + jnp.einsum('bhs,bhsk,bhsv->bhkv', wts, kc, vc)
        n = decay[..., None] * n + jnp.einsum('bhs,bhsk->bhk', wts, kc)
        return (C, n, m_new), h

    init = (jnp.zeros((B, H, d, d), F32), jnp.zeros((B, H, d), F32), jnp.full((B, H), -jnp.inf, F32))
    _, hs = lax.scan(step, init, xs)
    return jnp.moveaxis(hs, 0, 2).reshape(B, H, S, d)


def mixer_sublayer(x, cos, sin, w_in, sgu_ln_g, sgu_ln_b, w_spatial, b_spatial,
                   conv_w, conv_b, b_igate, b_fgate, head_norm_g, w_out):
    B, S, _ = x.shape
    (aq, ak, av, ag, su, sv, sg, mq, mk, mv, mo, mg, mi, mf) = split_columns(x @ w_in)

    nh = N_ATT_GROUPS * ATT_HEADS
    aq = apply_partial_rope(aq.reshape(B, S, nh, ATT_HEAD_DIM), cos, sin)
    ak = apply_partial_rope(ak.reshape(B, S, nh, ATT_HEAD_DIM), cos, sin)
    av = av.reshape(B, S, nh, ATT_HEAD_DIM)
    outs, lses = [], []
    for gi, (window, dilation) in enumerate(ATT_GROUPS):
        hs = slice(gi * ATT_HEADS, (gi + 1) * ATT_HEADS)
        o, lse = dilated_window_attention(aq[:, :, hs], ak[:, :, hs], av[:, :, hs], window, dilation)
        outs.append(o)
        lses.append(lse)
    wts = jax.nn.softmax(jnp.stack(lses), axis=0)
    att = jnp.einsum('gbsh,gbshc->bshc', wts, jnp.stack(outs)).reshape(B, S, ATT_WIDTH).astype(x.dtype)

    sgu = spatial_gating(jax.nn.gelu(su, approximate=False), jax.nn.gelu(sv, approximate=False),
                         sgu_ln_g, sgu_ln_b, w_spatial, b_spatial)

    qk = jax.nn.silu(causal_depthwise_conv(jnp.concatenate([mq, mk], axis=-1), conv_w, conv_b))
    mq, mk = jnp.split(qk, 2, axis=-1)

    def heads(t):
        return t.astype(F32).reshape(B, S, MLSTM_HEADS, MLSTM_HEAD_DIM).transpose(0, 2, 1, 3)

    ig = (mi.astype(F32) + b_igate).transpose(0, 2, 1)
    lf = jax.nn.log_sigmoid(mf.astype(F32) + b_fgate).transpose(0, 2, 1)
    h = mlstm_chunkwise(heads(mq), heads(mk) * (MLSTM_HEAD_DIM ** -0.5), heads(mv), ig, lf)
    h = h.transpose(0, 2, 1, 3).reshape(B, S, MLSTM_WIDTH) * jax.nn.sigmoid(mo.astype(F32))
    ml = head_norm(h, head_norm_g).astype(x.dtype)

    mix = jnp.concatenate([att * jax.nn.silu(ag), sgu * jax.nn.silu(sg), ml * jax.nn.silu(mg)], axis=-1)
    return (mix @ w_out).astype(x.dtype)


def setup_inputs(seed: int = 0) -> dict:
    key = jax.random.key(seed)
    ks = jax.random.split(key, 16)
    beta = (8.0 * DEPTH) ** -0.25
    x = jax.random.normal(ks[0], (BATCH, SEQ, D_MODEL), F32)
    positions = jnp.broadcast_to(jnp.arange(SEQ, dtype=jnp.int32)[None, :], (BATCH, SEQ))
    w_in = jax.random.normal(ks[1], (DEPTH, D_MODEL, D_IN), F32) * D_MODEL ** -0.5
    sgu_ln_g = 1.0 + 0.1 * jax.random.normal(ks[2], (DEPTH, SGU_WIDTH), F32)
    sgu_ln_b = 0.1 * jax.random.normal(ks[3], (DEPTH, SGU_WIDTH), F32)
    w_spatial = jax.random.normal(ks[4], (DEPTH, SGU_GROUPS, SGU_CHUNK, SGU_CHUNK), F32) * SGU_CHUNK ** -0.5
    b_spatial = 1.0 + 0.1 * jax.random.normal(ks[5], (DEPTH, SGU_GROUPS, SGU_CHUNK), F32)
    conv_w = jax.random.normal(ks[6], (DEPTH, CONV_WIDTH, 2 * MLSTM_WIDTH), F32) * CONV_WIDTH ** -0.5
    conv_b = 0.01 * jax.random.normal(ks[7], (DEPTH, 2 * MLSTM_WIDTH), F32)
    b_igate = 0.1 * jax.random.normal(ks[8], (DEPTH, MLSTM_HEADS), F32)
    b_fgate = jnp.linspace(3.0, 6.0, MLSTM_HEADS, dtype=F32)[None, :] + 0.1 * jax.random.normal(ks[9], (DEPTH, MLSTM_HEADS), F32)
    head_norm_g = 1.0 + 0.1 * jax.random.normal(ks[10], (DEPTH, MLSTM_WIDTH), F32)
    w_out = jax.random.normal(ks[11], (DEPTH, D_MIX, D_MODEL), F32) * (D_MIX ** -0.5) * beta
    ln_g = 1.0 + 0.1 * jax.random.normal(ks[12], (DEPTH, D_MODEL), F32)
    ln_b = 0.1 * jax.random.normal(ks[13], (DEPTH, D_MODEL), F32)
    return {'x': x, 'positions': positions, 'w_in': w_in, 'sgu_ln_g': sgu_ln_g, 'sgu_ln_b': sgu_ln_b,
            'w_spatial': w_spatial, 'b_spatial': b_spatial, 'conv_w': conv_w, 'conv_b': conv_b,
            'b_igate': b_igate, 'b_fgate': b_fgate, 'head_norm_g': head_norm_g, 'w_out': w_out,
            'ln_g': ln_g, 'ln_b': ln_b}


def reference(x, positions, w_in, sgu_ln_g, sgu_ln_b, w_spatial, b_spatial, conv_w, conv_b,
              b_igate, b_fgate, head_norm_g, w_out, ln_g, ln_b):
    alpha = (2.0 * DEPTH) ** 0.25
    cos, sin = rope_tables(positions)
    for l in range(DEPTH):
        y = mixer_sublayer(x, cos, sin, w_in[l], sgu_ln_g[l], sgu_ln_b[l], w_spatial[l], b_spatial[l],
                           conv_w[l], conv_b[l], b_igate[l], b_fgate[l], head_norm_g[l], w_out[l])
        x = layer_norm(alpha * x + y, ln_g[l], ln_b[l])
    return x
```

```cpp
#include <hip/hip_runtime.h>
#include <hip/hip_cooperative_groups.h>
#include <cstdio>
#include <cstdint>
namespace cg = cooperative_groups;
namespace pg8 {
#define PG8_LAS __attribute__((address_space(3)))
typedef unsigned short bf16_t;
typedef short bf16x8 __attribute__((ext_vector_type(8)));
typedef float f32x4 __attribute__((ext_vector_type(4)));
typedef unsigned u32x4 __attribute__((ext_vector_type(4)));
constexpr int BM = 256, BK = 64, HALF = 128, HTB = HALF * BK * 2  , STAGE_BYTES = 8 * HTB, NXCD = 8, WGM = 8;

__host__ __device__ __forceinline__ int lds_byte(int r, int c) { const int st = (r >> 4) * 2 + (c >> 5), rr = r & 15, cc = c & 31, ob = rr * 64 + cc * 2; return st * 1024 + (ob ^ (((ob >> 9) & 1) << 5)); }
__host__ __device__ __forceinline__ void stage_rc(int b, int& R, int& C) { const int st = b / 1024, sb = b % 1024, swz = sb ^ (((sb >> 9) & 1) << 5); R = (st >> 1) * 16 + swz / 64; C = (st & 1) * 32 + (swz % 64) / 2; }
__host__ __device__ __forceinline__ int perm32(int rho) { const int n = rho >> 4, i = rho & 15; return 8 * (i >> 2) + 4 * n + (i & 3); }

struct Unit { int pm, pn; };
struct Gemm { const bf16_t* A; const bf16_t* Bt; int M, N, K; };

struct StaticOrder {
    int nM, nN, nwg, G, c;
    __host__ __device__ void init(int M, int N, int G_, int c_) { nM = M / BM; nN = N / BM; nwg = nM * nN; G = G_; c = c_; }
    __host__ __device__ bool next(int i, Unit& u) const {
        const long L = (long)i * G + c; if (L >= nwg) return false;
        int wgid = (int)L; { const int q = nwg / NXCD, r = nwg % NXCD, xcd = wgid % NXCD, off = wgid / NXCD; wgid = (xcd < r ? xcd * (q + 1) : r * (q + 1) + (xcd - r) * q) + off; }
        const int nig = WGM * nN, gid = wgid / nig, fm = gid * WGM, gsz = (nM - fm) < WGM ? (nM - fm) : WGM;
        u.pm = fm + ((wgid % nig) % gsz); u.pn = (wgid % nig) / gsz; return true;
    }
    __device__ __forceinline__ void a_ready(const Unit&) const {}
    __device__ __forceinline__ void done(const Unit&) const {}
};

__device__ __forceinline__ unsigned cvt_pk_bf16(float lo, float hi) { unsigned r; asm volatile("v_cvt_pk_bf16_f32 %0, %1, %2" : "=v"(r) : "v"(lo), "v"(hi)); return r; }
typedef float f32x2 __attribute__((ext_vector_type(2)));
__device__ __forceinline__ f32x2 gelu_pk(f32x2 v) {
    const f32x2 av = __builtin_elementwise_abs(v), d = av * 0.2316418882f + 1.0f;
    f32x2 t; t.x = __builtin_amdgcn_rcpf(d.x); t.y = __builtin_amdgcn_rcpf(d.y);
    f32x2 q = t * 0.5307027145f + (-0.7265760135f); q = q * t + 0.7107068705f; q = q * t + (-0.142248368f); q = q * t + 0.127414796f; q = q * t;
    const f32x2 s = (v * v) * (-0.72134752044f);
    f32x2 e; e.x = __builtin_amdgcn_exp2f(s.x); e.y = __builtin_amdgcn_exp2f(s.y);
    const f32x2 m = v * (q * e), r = v - m;
    f32x2 o; o.x = v.x < 0.f ? m.x : r.x; o.y = v.y < 0.f ? m.y : r.y; return o;
}

template <int ACT  > struct EpiBf16 {
    static constexpr bool PERM = true, AFTER_DRAIN = false; static_assert(ACT == 0 || ACT == 1, "EpiBf16: ACT is 0 (none) or 1 (gelu_pk)");
    bf16_t* O; int ldc; const float* bias; int split_cols; size_t split_stride; float scale0;
    __device__ __forceinline__ void operator()(const f32x4 (&acc)[2][2][4][2], const Unit& u, int wr, int wc, int fr, int fq) const {
        const int row0 = u.pm * BM + wr * 64 + fr; int colt = u.pn * BM; bf16_t* base = O;
        float sc = 1.f; if (split_cols) { const int t = colt / split_cols; base += (size_t)t * split_stride; colt -= t * split_cols; if (t == 0) sc = scale0; }
        const int col0 = colt + wc * 32 + 8 * fq, bcol0 = u.pn * BM + wc * 32 + 8 * fq;
        f32x4 bv[2][2];
#pragma unroll
        for (int bj = 0; bj < 2; ++bj)
#pragma unroll
            for (int n = 0; n < 2; ++n) bv[bj][n] = bias ? *(const f32x4*)(bias + bcol0 + bj * HALF + 4 * n) : (f32x4){0.f, 0.f, 0.f, 0.f};
#pragma unroll
        for (int ai = 0; ai < 2; ++ai)
#pragma unroll
            for (int m = 0; m < 4; ++m) { bf16_t* rowp = base + (size_t)(row0 + ai * HALF + m * 16) * ldc + col0;
#pragma unroll
                for (int bj = 0; bj < 2; ++bj) { f32x4 v0 = acc[ai][bj][m][0] + bv[bj][0], v1 = acc[ai][bj][m][1] + bv[bj][1];
                    if (ACT == 1) { f32x2 a = gelu_pk((f32x2){v0[0], v0[1]}), b = gelu_pk((f32x2){v0[2], v0[3]}), c = gelu_pk((f32x2){v1[0], v1[1]}), d = gelu_pk((f32x2){v1[2], v1[3]});
                        v0 = (f32x4){a.x, a.y, b.x, b.y}; v1 = (f32x4){c.x, c.y, d.x, d.y}; }
                    v0 = v0 * sc; v1 = v1 * sc; u32x4 w; w.x = cvt_pk_bf16(v0[0], v0[1]); w.y = cvt_pk_bf16(v0[2], v0[3]); w.z = cvt_pk_bf16(v1[0], v1[1]); w.w = cvt_pk_bf16(v1[2], v1[3]);
                    *(u32x4*)(rowp + bj * HALF) = w; } }
    }
};
struct EpiResF32 {
    static constexpr bool PERM = true, AFTER_DRAIN = false;
    const float* R; float* O; int ldc; float alpha;
    __device__ __forceinline__ void operator()(const f32x4 (&acc)[2][2][4][2], const Unit& u, int wr, int wc, int fr, int fq) const {
        const int row0 = u.pm * BM + wr * 64 + fr, col0 = u.pn * BM + wc * 32 + 8 * fq;
#pragma unroll
        for (int ai = 0; ai < 2; ++ai)
#pragma unroll
            for (int m = 0; m < 4; ++m) {
                const size_t ro = (size_t)(row0 + ai * HALF + m * 16) * ldc + col0;
#pragma unroll
                for (int bj = 0; bj < 2; ++bj) {
                    const f32x4 r0 = *(const f32x4*)(R + ro + bj * HALF), r1 = *(const f32x4*)(R + ro + bj * HALF + 4);
                    *(f32x4*)(O + ro + bj * HALF) = r0 * alpha + acc[ai][bj][m][0];
                    *(f32x4*)(O + ro + bj * HALF + 4) = r1 * alpha + acc[ai][bj][m][1];
                }
            }
    }
};
template <class Epi, class Sched, bool ALIGN_EPI = false, bool SP2 = false>
__device__ __forceinline__ void gemm_phase(PG8_LAS unsigned char* lds, const Gemm g, const Sched& S, const Epi& E) {
    int tid_l = threadIdx.x; asm volatile("" : "+v"(tid_l));
    const int tid = tid_l, wid = __builtin_amdgcn_readfirstlane(tid >> 6), lane = tid & 63, wr = wid >> 2, wc = wid & 3, fr = lane & 15, fq = lane >> 4;
    const int K = g.K, nt = K / BK;
    unsigned voffA[2], voffB[2];
#pragma unroll
    for (int i = 0; i < 2; ++i) { int R, C; stage_rc(tid * 16 + i * 8192, R, C); const int Rb = Epi::PERM ? ((R & ~31) + perm32(R & 31)) : R;
        voffA[i] = (unsigned)(R * K + C) * 2u; voffB[i] = (unsigned)(Rb * K + C) * 2u; }
    const size_t kstep = (size_t)(BK * 2);
    const size_t hstep = (size_t)HALF * K * 2;
    const size_t tstep = 2 * hstep;
    const unsigned ldsw = (unsigned)wid * 1024u;
    const int aoff = lds_byte(wr * 64 + fr, fq * 8), boff = lds_byte(wc * 32 + fr, fq * 8);
#define PG8_SA(b, h) (((b) * 2 + (h)) * HTB)
#define PG8_SB(b, h) ((4 + (b) * 2 + (h)) * HTB)
#define PG8_STAGE(bufoff, gbase, voff) do { _Pragma("unroll") for (int _i = 0; _i < 2; ++_i) \
        __builtin_amdgcn_global_load_lds((const unsigned*)((const char*)(gbase) + (voff)[_i]), (PG8_LAS unsigned*)(lds + (bufoff) + ldsw + _i * 8192), 16, 0, 0); } while (0)
#define PG8_LDA(dst, b, h) do { _Pragma("unroll") for (int m = 0; m < 4; ++m) _Pragma("unroll") for (int k = 0; k < 2; ++k) dst[m][k] = *(const PG8_LAS bf16x8*)(lds + PG8_SA(b, h) + aoff + m * 2048 + k * 1024); } while (0)
#define PG8_LDB(dst, b, h) do { _Pragma("unroll") for (int n = 0; n < 2; ++n) _Pragma("unroll") for (int k = 0; k < 2; ++k) dst[n][k] = *(const PG8_LAS bf16x8*)(lds + PG8_SB(b, h) + boff + n * 2048 + k * 1024); } while (0)
#define PG8_MMA(ai, bj, At, Bt) do { __builtin_amdgcn_s_setprio(1); _Pragma("unroll") for (int m = 0; m < 4; ++m) _Pragma("unroll") for (int n = 0; n < 2; ++n) _Pragma("unroll") for (int k = 0; k < 2; ++k) \
        acc[ai][bj][m][n] = __builtin_amdgcn_mfma_f32_16x16x32_bf16(Bt[n][k], At[m][k], acc[ai][bj][m][n], 0, 0, 0); __builtin_amdgcn_s_setprio(0); } while (0)
#define PG8_WAIT_V(n) asm volatile("s_waitcnt vmcnt(" #n ")" ::: "memory")
#define PG8_WAIT_L(n) asm volatile("s_waitcnt lgkmcnt(" #n ")" ::: "memory")
#define PG8_BAR __builtin_amdgcn_s_barrier()
#define PG8_SCHED __builtin_amdgcn_sched_barrier(0)
    Unit cur, nxt; int ui = 0;
    if (!S.next(0, cur)) return;
    f32x4 acc[2][2][4][2];
#pragma unroll
    for (int a = 0; a < 2; ++a)
#pragma unroll
        for (int b = 0; b < 2; ++b)
#pragma unroll
            for (int m = 0; m < 4; ++m)
#pragma unroll
                for (int n = 0; n < 2; ++n) acc[a][b][m][n] = (f32x4){0.f, 0.f, 0.f, 0.f};
    bf16x8 At[4][2], B0[2][2], B1[2][2];
    const char* cA = (const char*)g.A + (size_t)cur.pm * tstep; const char* cB = (const char*)g.Bt + (size_t)cur.pn * tstep;
    S.a_ready(cur);
    if constexpr (SP2) {
        PG8_STAGE(PG8_SB(0, 0), cB, voffB); PG8_STAGE(PG8_SB(0, 1), cB + hstep, voffB); PG8_STAGE(PG8_SA(0, 0), cA, voffA); PG8_STAGE(PG8_SA(0, 1), cA + hstep, voffA);
        if (wr == 1) PG8_BAR;
        PG8_WAIT_V(2); PG8_BAR;
        PG8_STAGE(PG8_SB(1, 0), cB + kstep, voffB); PG8_STAGE(PG8_SA(1, 0), cA + kstep, voffA); PG8_STAGE(PG8_SB(1, 1), cB + hstep + kstep, voffB);
        PG8_WAIT_V(6); PG8_BAR;
    } else {
        PG8_STAGE(PG8_SB(0, 0), cB, voffB); PG8_STAGE(PG8_SA(0, 0), cA, voffA); PG8_STAGE(PG8_SB(0, 1), cB + hstep, voffB); PG8_STAGE(PG8_SA(0, 1), cA + hstep, voffA);
        if (wr == 1) PG8_BAR;
        PG8_WAIT_V(4); PG8_BAR;
        PG8_STAGE(PG8_SB(1, 0), cB + kstep, voffB); PG8_STAGE(PG8_SA(1, 0), cA + kstep, voffA); PG8_STAGE(PG8_SB(1, 1), cB + hstep + kstep, voffB);
        PG8_WAIT_V(6); PG8_BAR;
    }
    for (;;) {
        const bool has_next = S.next(ui + 1, nxt);
        const char* nA = has_next ? (const char*)g.A + (size_t)nxt.pm * tstep : cA; const char* nB = has_next ? (const char*)g.Bt + (size_t)nxt.pn * tstep : cB;
        for (int t = 0; t < nt; t += 2) {
            const bool last = (t == nt - 2);
            const char* a1 = cA + (size_t)(t + 1) * kstep;
            const char* a2 = last ? nA : cA + (size_t)(t + 2) * kstep; const char* b2 = last ? nB : cB + (size_t)(t + 2) * kstep;
            const char* a3 = a2 + kstep; const char* b3 = b2 + kstep;
            if (last && has_next) S.a_ready(nxt);
            if constexpr (SP2) {
            PG8_LDB(B0, 0, 0); PG8_LDB(B1, 0, 1); PG8_SCHED; PG8_LDA(At, 0, 0); PG8_STAGE(PG8_SA(1, 1), a1 + hstep, voffA);
            PG8_WAIT_V(8); PG8_WAIT_L(0); PG8_BAR; PG8_MMA(0, 0, At, B0); PG8_MMA(0, 1, At, B1); PG8_BAR; PG8_SCHED;
            PG8_LDA(At, 0, 1); PG8_STAGE(PG8_SB(0, 0), b2, voffB); PG8_STAGE(PG8_SB(0, 1), b2 + hstep, voffB); PG8_STAGE(PG8_SA(0, 0), a2, voffA);
            PG8_WAIT_V(8); PG8_WAIT_L(0); PG8_BAR; PG8_MMA(1, 0, At, B0); PG8_MMA(1, 1, At, B1); PG8_BAR; PG8_SCHED;
            PG8_LDB(B0, 1, 0); PG8_LDB(B1, 1, 1); PG8_SCHED; PG8_LDA(At, 1, 0); PG8_STAGE(PG8_SA(0, 1), a2 + hstep, voffA);
            PG8_WAIT_V(8); PG8_WAIT_L(0); PG8_BAR; PG8_MMA(0, 0, At, B0); PG8_MMA(0, 1, At, B1); PG8_BAR; PG8_SCHED;
            PG8_LDA(At, 1, 1); PG8_STAGE(PG8_SB(1, 0), b3, voffB); PG8_STAGE(PG8_SB(1, 1), b3 + hstep, voffB); PG8_STAGE(PG8_SA(1, 0), a3, voffA);
            PG8_WAIT_V(8); PG8_WAIT_L(0); PG8_BAR; PG8_MMA(1, 0, At, B0); PG8_MMA(1, 1, At, B1); PG8_BAR; PG8_SCHED;
            } else {
            PG8_LDB(B0, 0, 0); PG8_SCHED; PG8_LDA(At, 0, 0); PG8_STAGE(PG8_SA(1, 1), a1 + hstep, voffA);
            PG8_WAIT_L(8); PG8_BAR; PG8_WAIT_L(0); PG8_MMA(0, 0, At, B0); PG8_BAR; PG8_SCHED;
            PG8_LDB(B1, 0, 1); PG8_STAGE(PG8_SB(0, 0), b2, voffB);
            PG8_BAR; PG8_WAIT_L(0); PG8_MMA(0, 1, At, B1); PG8_BAR;
            PG8_LDA(At, 0, 1); PG8_STAGE(PG8_SA(0, 0), a2, voffA);
            PG8_BAR; PG8_WAIT_L(0); PG8_MMA(1, 0, At, B0); PG8_BAR; PG8_SCHED;
            PG8_STAGE(PG8_SB(0, 1), b2 + hstep, voffB);
            PG8_WAIT_V(6); PG8_BAR; PG8_MMA(1, 1, At, B1); PG8_BAR;
            PG8_LDB(B0, 1, 0); PG8_SCHED; PG8_LDA(At, 1, 0); PG8_STAGE(PG8_SA(0, 1), a2 + hstep, voffA);
            PG8_WAIT_L(8); PG8_BAR; PG8_WAIT_L(0); PG8_MMA(0, 0, At, B0); PG8_BAR; PG8_SCHED;
            PG8_LDB(B1, 1, 1); PG8_STAGE(PG8_SB(1, 0), b3, voffB);
            PG8_BAR; PG8_WAIT_L(0); PG8_MMA(0, 1, At, B1); PG8_BAR;
            PG8_LDA(At, 1, 1); PG8_STAGE(PG8_SA(1, 0), a3, voffA);
            PG8_BAR; PG8_WAIT_L(0); PG8_MMA(1, 0, At, B0); PG8_BAR; PG8_SCHED;
            PG8_STAGE(PG8_SB(1, 1), b3 + hstep, voffB);
            PG8_WAIT_V(6); PG8_BAR; PG8_MMA(1, 1, At, B1); PG8_BAR;
            }
        }
        if constexpr (ALIGN_EPI) { if (wr == 0) PG8_BAR; }
        if constexpr (!Epi::AFTER_DRAIN) { E(acc, cur, wr, wc, fr, fq); S.done(cur); }
        if (!has_next) break;
#pragma unroll
        for (int a = 0; a < 2; ++a)
#pragma unroll
            for (int b = 0; b < 2; ++b)
#pragma unroll
                for (int m = 0; m < 4; ++m)
#pragma unroll
                    for (int n = 0; n < 2; ++n) acc[a][b][m][n] = (f32x4){0.f, 0.f, 0.f, 0.f};
        cur = nxt; cA = nA; cB = nB; ++ui;
        if constexpr (ALIGN_EPI) { if (wr == 1) PG8_BAR; }
    }
    PG8_WAIT_V(0);
    if constexpr (!ALIGN_EPI) { if (wr == 0) PG8_BAR; }
    PG8_BAR;
    if constexpr (Epi::AFTER_DRAIN) { E.fused(acc, cur, wr, wc, fr, fq, lds, wid, lane); S.done(cur); }
#undef PG8_SA
#undef PG8_SB
#undef PG8_STAGE
#undef PG8_LDA
#undef PG8_LDB
#undef PG8_MMA
#undef PG8_WAIT_V
#undef PG8_WAIT_L
#undef PG8_BAR
#undef PG8_SCHED
}
}

constexpr int NB = 8, SEQ = 4096, M = NB * SEQ, D = 2048, DIN = 11784, NZ = 11776, DEPTH = 2;
constexpr int Z_AQ = 0, Z_AK = 1536, Z_AV = 3072, Z_AG = 4608, Z_SU = 5120, Z_SV = 5632, Z_SG = 6144, Z_MQ = 6656, Z_MK = 7680, Z_MV = 8704, Z_MO = 9728, Z_MG = 10752;
constexpr size_t MiB = 1u << 20;
constexpr size_t WIN_BYTES = (size_t)NZ * D * 2, WOUT_BYTES = (size_t)D * D * 2;
constexpr size_t WS_WIN = 1 * MiB, WS_WOUT = WS_WIN + 2 * WIN_BYTES, WS_GATES = WS_WOUT + 2 * WOUT_BYTES, WS_LSE = WS_GATES + (size_t)M * 8 * 4;
constexpr size_t WS_XB = 114 * MiB, WS_Z = WS_XB + (size_t)M * D * 2, WS_END = WS_Z + (size_t)M * NZ * 2;
static_assert(WS_LSE + (size_t)M * 24 * 4 <= WS_XB, "ws map");
constexpr int LDS_BYTES = 159744;
constexpr float LN_EPS = 1e-5f;

typedef unsigned short bf16;
typedef short bf16x8 __attribute__((ext_vector_type(8)));
typedef float f32x4 __attribute__((ext_vector_type(4)));
typedef unsigned u32x4 __attribute__((ext_vector_type(4)));
typedef unsigned u32x2 __attribute__((ext_vector_type(2)));
typedef short s16x4 __attribute__((ext_vector_type(4)));
#define LAS __attribute__((address_space(3)))

struct Args {
    const float* x; const int* pos; const float* w_in; const float* sgu_ln_g; const float* sgu_ln_b; const float* w_spatial; const float* b_spatial;
    const float* conv_w; const float* conv_b; const float* b_igate; const float* b_fgate; const float* head_norm_g; const float* w_out; const float* ln_g; const float* ln_b;
    float* out; unsigned char* ws;
};

__device__ __forceinline__ float bflo(unsigned w) { return __builtin_bit_cast(float, w << 16); }
__device__ __forceinline__ float bfhi(unsigned w) { return __builtin_bit_cast(float, w & 0xffff0000u); }
__device__ __forceinline__ float bf1(bf16 u) { return __builtin_bit_cast(float, (unsigned)u << 16); }
typedef float f32x2_t __attribute__((ext_vector_type(2)));
typedef __bf16 bf16x2_t __attribute__((ext_vector_type(2)));
__device__ __forceinline__ unsigned pk2(float lo, float hi) { const f32x2_t v = {lo, hi}; return __builtin_bit_cast(unsigned, __builtin_convertvector(v, bf16x2_t)); }
__device__ __forceinline__ unsigned f2bf(float f) { return pk2(f, 0.f) & 0xffffu; }
#define UNPACK8(v, f) do { f[0] = bflo(v.x); f[1] = bfhi(v.x); f[2] = bflo(v.y); f[3] = bfhi(v.y); f[4] = bflo(v.z); f[5] = bfhi(v.z); f[6] = bflo(v.w); f[7] = bfhi(v.w); } while (0)
#define PACK8(f) ((u32x4){pk2(f[0], f[1]), pk2(f[2], f[3]), pk2(f[4], f[5]), pk2(f[6], f[7])})
__device__ __forceinline__ float silu_f(float y) { return y / (1.f + __expf(-y)); }
__device__ __forceinline__ float sigmoid_f(float y) { return 1.f / (1.f + __expf(-y)); }
__device__ __forceinline__ float gelu_f(float v) {
    const float av = fabsf(v), t = __builtin_amdgcn_rcpf(av * 0.2316418882f + 1.0f);
    float q = t * 0.5307027145f + (-0.7265760135f); q = q * t + 0.7107068705f; q = q * t + (-0.142248368f); q = q * t + 0.127414796f; q = q * t;
    const float e = __builtin_amdgcn_exp2f((v * v) * (-0.72134752044f));
    const float m = v * (q * e);
    return v < 0.f ? m : v - m;
}
__device__ __forceinline__ f32x4 mfma16(bf16x8 a, bf16x8 b, f32x4 c) { return __builtin_amdgcn_mfma_f32_16x16x32_bf16(a, b, c, 0, 0, 0); }
__device__ __forceinline__ bf16x8 frag_kc(const LAS bf16* base, int ld, int r0, int k0, int lane) {
    return *(const LAS bf16x8*)(base + (r0 + (lane & 15)) * ld + k0 + 8 * (lane >> 4));
}
__device__ __forceinline__ s16x4 tr_rd(const LAS bf16* p) { return __builtin_bit_cast(s16x4, __builtin_amdgcn_ds_read_tr16_b64_v4i16((LAS s16x4*)p)); }
__device__ __forceinline__ bf16x8 frag_ks(const LAS bf16* base, int ld, int k0, int r0, int lane) {
    const int g = lane >> 4, q = (lane & 15) >> 2, p = lane & 3;
    const LAS bf16* a = base + (k0 + 8 * g + q) * ld + r0 + 4 * p;
    const s16x4 lo = tr_rd(a), hi = tr_rd(a + 4 * ld);
    return (bf16x8){lo[0], lo[1], lo[2], lo[3], hi[0], hi[1], hi[2], hi[3]};
}
__device__ __forceinline__ float wave_sum(float v) {
#pragma unroll
    for (int o = 1; o < 64; o <<= 1) v += __shfl_xor(v, o);
    return v;
}
__device__ __forceinline__ float sum16(float v) { v += __shfl_xor(v, 1); v += __shfl_xor(v, 2); v += __shfl_xor(v, 4); v += __shfl_xor(v, 8); return v; }
__device__ __forceinline__ float max16(float v) { v = fmaxf(v, __shfl_xor(v, 1)); v = fmaxf(v, __shfl_xor(v, 2)); v = fmaxf(v, __shfl_xor(v, 4)); v = fmaxf(v, __shfl_xor(v, 8)); return v; }
#define LDS_WAIT() asm volatile("s_waitcnt lgkmcnt(0)" ::: "memory")
#define OPQ(x) asm volatile("" : "+s"(x))
typedef const Args __attribute__((address_space(4)))* KArgs;
__device__ __forceinline__ Args load_args(KArgs p) {
#if defined(__HIP_DEVICE_COMPILE__)
    asm volatile("" : "+s"(p)); return *p;
#else
    return Args{};
#endif
}
__device__ __forceinline__ int opq_tid() { int t = threadIdx.x; asm volatile("" : "+v"(t)); return t; }

__device__ __forceinline__ void transpose_item(const float* W, int ldw, int K, bf16* WT, LAS float* scr, int item, int nblk, int lane) {
    const int kb = item / nblk, nb = item % nblk, k0 = 64 * kb, n0 = 32 * nb;
#pragma unroll 8
    for (int i = 0; i < 32; ++i) { const int kk = 2 * i + (lane >> 5); scr[kk * 33 + (lane & 31)] = W[(size_t)(k0 + kk) * ldw + n0 + (lane & 31)]; }
    LDS_WAIT();
    const int c = lane & 7;
#pragma unroll
    for (int j = 0; j < 4; ++j) { const int n = (lane >> 3) + 8 * j; const LAS float* s = scr + (8 * c) * 33 + n;
        u32x4 o; o.x = pk2(s[0 * 33], s[1 * 33]); o.y = pk2(s[2 * 33], s[3 * 33]); o.z = pk2(s[4 * 33], s[5 * 33]); o.w = pk2(s[6 * 33], s[7 * 33]);
        *(u32x4*)(WT + (size_t)(n0 + n) * K + k0 + 8 * c) = o; }
    LDS_WAIT();
}
__device__ __forceinline__ void load_gate_w(const float* w_in_l, LAS f32x4* wg) {
    for (int idx = opq_tid(); idx < 4096; idx += 512) { const int k = idx >> 1, hh = idx & 1, i = k >> 8, ln = (k & 255) >> 2, e = k & 3;
        wg[((i * 4 + e) * 2 + hh) * 64 + ln] = *(const f32x4*)(w_in_l + (size_t)k * DIN + NZ + 4 * hh); }
}
__device__ __forceinline__ void gate_dots(const f32x4 (&v)[8], const LAS f32x4* wg, float* gates, int lane) {
    f32x4 a0 = {0.f, 0.f, 0.f, 0.f}, a1 = {0.f, 0.f, 0.f, 0.f};
#pragma unroll
    for (int i = 0; i < 8; ++i)
#pragma unroll
        for (int e = 0; e < 4; ++e) { const f32x4 w0 = wg[((i * 4 + e) * 2 + 0) * 64 + lane], w1 = wg[((i * 4 + e) * 2 + 1) * 64 + lane]; a0 += w0 * v[i][e]; a1 += w1 * v[i][e];
            if (e == 3) __builtin_amdgcn_sched_barrier(0); }
#pragma unroll
    for (int e = 0; e < 4; ++e) { a0[e] = wave_sum(a0[e]); a1[e] = wave_sum(a1[e]); }
    if (lane == 0) { *(f32x4*)gates = a0; *(f32x4*)(gates + 4) = a1; }
}
__device__ __forceinline__ void p0_prologue(KArgs kp, LAS unsigned char* lds, int G) {
    const Args A = load_args(kp);
    unsigned char* ws = A.ws; OPQ(ws);
    const int tid = opq_tid(), lane = tid & 63, wave = tid >> 6;
    const int gw = blockIdx.x * 8 + wave, NGW = G * 8;
    LAS float* scr = (LAS float*)(lds + wave * 16384);
    constexpr int I_IN = (D / 64) * (NZ / 32), I_OUT = (D / 64) * (D / 32);
    for (int it = gw; it < 2 * (I_IN + I_OUT); it += NGW) {
        int r = it; const int l = r / (I_IN + I_OUT); r -= l * (I_IN + I_OUT);
        if (r < I_IN) transpose_item(A.w_in + (size_t)l * D * DIN, DIN, D, (bf16*)(ws + WS_WIN + l * WIN_BYTES), scr, r, NZ / 32, lane);
        else transpose_item(A.w_out + (size_t)l * D * D, D, D, (bf16*)(ws + WS_WOUT + l * WOUT_BYTES), scr, r - I_IN, D / 32, lane);
    }
    __syncthreads();
    LAS f32x4* wg = (LAS f32x4*)lds;
    load_gate_w(A.w_in, wg);
    __syncthreads();
    bf16* XB = (bf16*)(ws + WS_XB); float* GT = (float*)(ws + WS_GATES);
    for (int m = gw; m < M; m += NGW) {
        const f32x4* xr = (const f32x4*)(A.x + (size_t)m * D) + lane;
        f32x4 v[8];
#pragma unroll
        for (int i = 0; i < 8; ++i) v[i] = xr[64 * i];
        u32x2* o = (u32x2*)(XB + (size_t)m * D) + lane;
#pragma unroll
        for (int i = 0; i < 8; ++i) o[64 * i] = (u32x2){pk2(v[i][0], v[i][1]), pk2(v[i][2], v[i][3])};
        gate_dots(v, wg, GT + (size_t)m * 8, lane);
    }
    __syncthreads();
}

__device__ __forceinline__ void conv_unit(KArgs kp, int l, int u) {
    const Args A = load_args(kp);
    unsigned char* ws = A.ws; OPQ(ws); OPQ(l);
    const int tid = opq_tid(), cgp = tid & 255, half = tid >> 8, c0 = 8 * cgp, r0 = 32 * u + 16 * half;
    const bf16* Z = (const bf16*)(ws + WS_Z); bf16* Q = (bf16*)(ws + WS_XB);
    const float* cw = A.conv_w + (size_t)l * 4 * 2048 + c0; const float* cb = A.conv_b + (size_t)l * 2048 + c0;
    const bf16* zp = Z + (size_t)r0 * NZ + Z_MQ + c0;
    u32x4 rows[19];
    const bool hist = (r0 & (SEQ - 1)) != 0;
#pragma unroll
    for (int t = 0; t < 3; ++t) { rows[t] = (u32x4){0u, 0u, 0u, 0u}; if (hist) rows[t] = *(const u32x4*)(zp + (size_t)(t - 3) * NZ); }
#pragma unroll
    for (int t = 0; t < 16; ++t) rows[3 + t] = *(const u32x4*)(zp + (size_t)t * NZ);
    float w0[8], w1[8], w2[8], w3[8], bb[8], x3[8], x2[8], x1[8], cur[8], y[8];
#pragma unroll
    for (int e = 0; e < 8; ++e) { w0[e] = cw[e]; w1[e] = cw[2048 + e]; w2[e] = cw[4096 + e]; w3[e] = cw[6144 + e]; bb[e] = cb[e]; }
    UNPACK8(rows[0], x3); UNPACK8(rows[1], x2); UNPACK8(rows[2], x1);
    const float sc = (c0 >= 1024) ? 0.0625f : 1.f;
#pragma unroll
    for (int t = 0; t < 16; ++t) {
        UNPACK8(rows[3 + t], cur);
#pragma unroll
        for (int e = 0; e < 8; ++e) { const float sv = bb[e] + w0[e] * x3[e] + w1[e] * x2[e] + w2[e] * x1[e] + w3[e] * cur[e]; y[e] = silu_f(sv) * sc; x3[e] = x2[e]; x2[e] = x1[e]; x1[e] = cur[e]; }
        *(u32x4*)(Q + (size_t)(r0 + t) * 2048 + c0) = PACK8(y);
    }
}

constexpr int SGU_VLD = 520;
__device__ __forceinline__ void sgu_unit(KArgs kp, int l, int u, LAS unsigned char* lds, bool dry = false) {
    const Args A = load_args(kp);
    unsigned char* ws = A.ws; OPQ(ws); OPQ(l);
    const int tid = opq_tid(), lane = tid & 63, w = tid >> 6;
    bf16* Z = (bf16*)(ws + WS_Z);
    LAS bf16* VN = (LAS bf16*)lds;
    const size_t t0 = (size_t)u * 128;
    {
        u32x4 raw[16];
#pragma unroll
        for (int tt = 0; tt < 16; ++tt) raw[tt] = *(const u32x4*)(Z + (t0 + 16 * w + tt) * NZ + Z_SV + 8 * lane);
#pragma unroll
        for (int tt = 0; tt < 16; ++tt) *(LAS u32x4*)(VN + (16 * w + tt) * SGU_VLD + 8 * lane) = raw[tt];
        float g8[8], b8[8];
#pragma unroll
        for (int e = 0; e < 8; ++e) { g8[e] = A.sgu_ln_g[l * 512 + 8 * lane + e]; b8[e] = A.sgu_ln_b[l * 512 + 8 * lane + e]; }
#pragma unroll 1
        for (int tt = 0; tt < 16; ++tt) { const int t = 16 * w + tt;
            const u32x4 rv = *(const LAS u32x4*)(VN + t * SGU_VLD + 8 * lane); float f[8]; UNPACK8(rv, f);
            float sm = 0.f;
#pragma unroll
            for (int e = 0; e < 8; ++e) { f[e] = gelu_f(f[e]); sm += f[e]; }
            const float mean = wave_sum(sm) * (1.f / 512.f); float q = 0.f;
#pragma unroll
            for (int e = 0; e < 8; ++e) { f[e] -= mean; q += f[e] * f[e]; }
            const float rstd = rsqrtf(wave_sum(q) * (1.f / 512.f) + LN_EPS);
#pragma unroll
            for (int e = 0; e < 8; ++e) f[e] = f[e] * rstd * g8[e] + b8[e];
            *(LAS u32x4*)(VN + t * SGU_VLD + 8 * lane) = PACK8(f);
        }
    }
    __syncthreads();
    const int fr = lane & 15, fq = lane >> 4, trow = 16 * w + fr;
    bf16* zr = Z + (t0 + trow) * NZ;
#pragma unroll 1
    for (int g = 0; g < 4; ++g) {
        f32x4 acc[8];
#pragma unroll
        for (int mt = 0; mt < 8; ++mt) acc[mt] = (f32x4){0.f, 0.f, 0.f, 0.f};
        u32x2 su2[8], sg2[8];
#pragma unroll
        for (int mt = 0; mt < 8; ++mt) { su2[mt] = *(const u32x2*)(zr + Z_SU + g * 128 + 16 * mt + 4 * fq); sg2[mt] = *(const u32x2*)(zr + Z_SG + g * 128 + 16 * mt + 4 * fq); }
        const float* wrow = A.w_spatial + (((size_t)l * 4 + g) * 128 + trow) * 128;
        const float bs = A.b_spatial[((size_t)l * 4 + g) * 128 + trow];
        for (int ks = 0; ks <= (w >> 1); ++ks) {
            const int s0 = 32 * ks + 8 * fq;
            const f32x4 wa = *(const f32x4*)(wrow + s0), wb = *(const f32x4*)(wrow + s0 + 4);
            float wf[8] = {wa[0], wa[1], wa[2], wa[3], wb[0], wb[1], wb[2], wb[3]};
#pragma unroll
            for (int e = 0; e < 8; ++e) wf[e] = (s0 + e <= trow) ? wf[e] : 0.f;
            const u32x4 bp = PACK8(wf); const bf16x8 bfrag = __builtin_bit_cast(bf16x8, bp);
#pragma unroll
            for (int mt = 0; mt < 8; ++mt) acc[mt] = mfma16(frag_ks(VN, SGU_VLD, 32 * ks, g * 128 + 16 * mt, lane), bfrag, acc[mt]);
        }
#pragma unroll
        for (int mt = 0; mt < 8; ++mt) {
            const float u0 = gelu_f(bflo(su2[mt].x)), u1 = gelu_f(bfhi(su2[mt].x)), u2 = gelu_f(bflo(su2[mt].y)), u3 = gelu_f(bfhi(su2[mt].y));
            const float g0 = silu_f(bflo(sg2[mt].x)), g1 = silu_f(bfhi(sg2[mt].x)), g2 = silu_f(bflo(sg2[mt].y)), g3 = silu_f(bfhi(sg2[mt].y));
            const u32x2 o = {pk2(u0 * (acc[mt][0] + bs) * g0, u1 * (acc[mt][1] + bs) * g1), pk2(u2 * (acc[mt][2] + bs) * g2, u3 * (acc[mt][3] + bs) * g3)};
            *(u32x2*)(dry ? (bf16*)ws + tid * 64 : zr + Z_SU + g * 128 + 16 * mt + 4 * fq) = o;
        }
    }
    __syncthreads();
}

constexpr int AT_LD = 72, AT_PLD = 168;
constexpr int AT_Q = 0, AT_K = AT_Q + 128 * AT_LD * 2, AT_V = AT_K + 256 * AT_LD * 2, AT_P = AT_V + 272 * AT_LD * 2, AT_END = AT_P + 8 * 16 * AT_PLD * 2;
static_assert(AT_END <= LDS_BYTES, "attention LDS");
struct AttnId { int g, b, h, r, n, d, hc; };
__device__ __forceinline__ AttnId attn_decode(int slot) {
    const int u = (slot & ~63) | ((slot & 7) << 3) | ((slot >> 3) & 7);
    AttnId a; a.g = u >> 11; const int rem = u & 2047; a.b = rem >> 8; a.h = (rem >> 5) & 7; const int rn = rem & 31;
    const int dsh = 2 * a.g, nbsh = 5 - dsh; a.d = 1 << dsh; a.r = rn >> nbsh; a.n = rn & ((1 << nbsh) - 1); a.hc = (a.g * 8 + a.h) * 64; return a;
}
__device__ __forceinline__ void attn_issue(const bf16* Z, const int* posp, const AttnId& a, int tid, u32x4 (&pr)[11], int& ppos) {
    const size_t tokb = (size_t)a.b * SEQ;
#pragma unroll
    for (int i = 0; i < 11; ++i) pr[i] = (u32x4){0u, 0u, 0u, 0u};
    ppos = 0;
    if (tid < 384) {
        const int isK = tid >= 128, idx = isK ? tid - 128 : tid, isub = isK ? 128 * (a.n - 1) + idx : 128 * a.n + idx;
        if (isub >= 0) { const size_t tok = tokb + (size_t)isub * a.d + a.r; const bf16* src = Z + tok * NZ + (isK ? Z_AK : Z_AQ) + a.hc;
            pr[0] = *(const u32x4*)src; pr[1] = *(const u32x4*)(src + 8); ppos = posp[tok]; }
    }
#pragma unroll
    for (int k = 0; k < 5; ++k) { const int idx = tid + 512 * k;
        if (idx < 2304) { const int row = idx / 6, ch = 2 + idx % 6, isK = row >= 128, ri = isK ? row - 128 : row, isub = isK ? 128 * (a.n - 1) + ri : 128 * a.n + ri;
            if (isub >= 0) pr[2 + k] = *(const u32x4*)(Z + (tokb + (size_t)isub * a.d + a.r) * NZ + (isK ? Z_AK : Z_AQ) + a.hc + 8 * ch); } }
#pragma unroll
    for (int k = 0; k < 4; ++k) { const int idx = tid + 512 * k, row = idx >> 3, ch = idx & 7, isub = 128 * (a.n - 1) + row;
        if (isub >= 0) pr[7 + k] = *(const u32x4*)(Z + (tokb + (size_t)isub * a.d + a.r) * NZ + Z_AV + a.hc + 8 * ch); }
}
__device__ __forceinline__ void attn_commit(LAS unsigned char* lds, int tid, const u32x4 (&pr)[11], int ppos) {
    LAS bf16* Qs = (LAS bf16*)(lds + AT_Q); LAS bf16* Ks = (LAS bf16*)(lds + AT_K); LAS bf16* Vs = (LAS bf16*)(lds + AT_V);
    if (tid < 384) {
        const int isK = tid >= 128, idx = isK ? tid - 128 : tid;
        LAS bf16* dst = (isK ? Ks : Qs) + idx * AT_LD;
        float t1[8], t2[8]; UNPACK8(pr[0], t1); UNPACK8(pr[1], t2);
        const float pos = (float)ppos;
        const float invf[8] = {1.0f, 0.19392274474868576f, 0.03760603093086393f, 0.007292664737217109f, 0.001414213562373095f, 0.0002742481756762073f, 5.318295896944988e-05f, 1.031338537721246e-05f};
#pragma unroll
        for (int i = 0; i < 8; ++i) {
            const float ang = pos * invf[i], k = rintf(ang * 0.15915494309189535f);
            float rr = fmaf(-k, 6.2831854820251465f, ang); rr = fmaf(-k, -1.7484555e-7f, rr);
            const float cs = __cosf(rr), sn = __sinf(rr);
            const float a1 = t1[i] * cs - t2[i] * sn, a2 = t2[i] * cs + t1[i] * sn; t1[i] = a1; t2[i] = a2;
        }
        *(LAS u32x4*)dst = PACK8(t1); *(LAS u32x4*)(dst + 8) = PACK8(t2);
    }
#pragma unroll
    for (int k = 0; k < 5; ++k) { const int idx = tid + 512 * k;
        if (idx < 2304) { const int row = idx / 6, ch = 2 + idx % 6, isK = row >= 128, ri = isK ? row - 128 : row;
            *(LAS u32x4*)((isK ? Ks : Qs) + ri * AT_LD + 8 * ch) = pr[2 + k]; } }
#pragma unroll
    for (int k = 0; k < 4; ++k) { const int idx = tid + 512 * k, row = idx >> 3, ch = idx & 7; *(LAS u32x4*)(Vs + row * AT_LD + 8 * ch) = pr[7 + k]; }
}
__device__ __forceinline__ bf16x8 frag_ks_pair(const LAS bf16* base, int ld, int k0, int r0, int lane) {
    const int g = lane >> 4, q = (lane & 15) >> 2, p = lane & 3;
    const LAS bf16* a = base + (k0 + 4 * g + q) * ld + r0 + 4 * p;
    const s16x4 lo = tr_rd(a), hi = tr_rd(a + 16 * ld);
    return (bf16x8){lo[0], lo[1], lo[2], lo[3], hi[0], hi[1], hi[2], hi[3]};
}
__device__ __forceinline__ void attn_compute(bf16* Z, float* LSE, const AttnId& a, LAS unsigned char* lds, int tid, bool dry, unsigned char* ws) {
    const int lane = tid & 63, w = tid >> 6, fr = lane & 15, fq = lane >> 4, n = a.n;
    LAS bf16* Qs = (LAS bf16*)(lds + AT_Q); LAS bf16* Ks = (LAS bf16*)(lds + AT_K); LAS bf16* Vs = (LAS bf16*)(lds + AT_V);
    const bf16x8 q0 = frag_kc(Qs, AT_LD, 16 * w, 0, lane), q1 = frag_kc(Qs, AT_LD, 16 * w, 32, lane);
    f32x4 s[10];
    float mx = -INFINITY;
#pragma unroll
    for (int tt = 0; tt < 9; ++tt) { const int kt = w + tt;
        f32x4 acc = {0.f, 0.f, 0.f, 0.f};
        acc = mfma16(frag_kc(Ks, AT_LD, 16 * kt, 0, lane), q0, acc); acc = mfma16(frag_kc(Ks, AT_LD, 16 * kt, 32, lane), q1, acc);
        const bool tile_ok = (n > 0) || (kt >= 8);
#pragma unroll
        for (int j = 0; j < 4; ++j) { const int dl = fr - 4 * fq - j; const bool ok = tile_ok && (tt == 0 ? dl <= 0 : (tt == 8 ? dl >= 0 : true));
            acc[j] = ok ? acc[j] * 0.125f : -INFINITY; mx = fmaxf(mx, acc[j]); }
        s[tt] = acc;
    }
    mx = fmaxf(mx, __shfl_xor(mx, 16)); mx = fmaxf(mx, __shfl_xor(mx, 32));
    float ls = 0.f;
#pragma unroll
    for (int tt = 0; tt < 9; ++tt)
#pragma unroll
        for (int j = 0; j < 4; ++j) { const float p = __expf(s[tt][j] - mx); ls += p; s[tt][j] = p; }
    s[9] = (f32x4){0.f, 0.f, 0.f, 0.f};
    ls += __shfl_xor(ls, 16); ls += __shfl_xor(ls, 32);
    f32x4 o[4];
#pragma unroll
    for (int nt = 0; nt < 4; ++nt) o[nt] = (f32x4){0.f, 0.f, 0.f, 0.f};
#pragma unroll
    for (int k2 = 0; k2 < 5; ++k2) {
        const u32x4 pp = {pk2(s[2 * k2][0], s[2 * k2][1]), pk2(s[2 * k2][2], s[2 * k2][3]), pk2(s[2 * k2 + 1][0], s[2 * k2 + 1][1]), pk2(s[2 * k2 + 1][2], s[2 * k2 + 1][3])};
        const bf16x8 pf = __builtin_bit_cast(bf16x8, pp);
#pragma unroll
        for (int nt = 0; nt < 4; ++nt) o[nt] = mfma16(frag_ks_pair(Vs, AT_LD, 16 * (w + 2 * k2), 16 * nt, lane), pf, o[nt]); }
    const int isub = 128 * n + 16 * w + fr; const size_t tok = (size_t)a.b * SEQ + (size_t)isub * a.d + a.r; const float inv = 1.f / ls;
    bf16* orow = dry ? (bf16*)ws + tid * 64 : Z + tok * NZ + Z_AQ + a.hc;
#pragma unroll
    for (int nt = 0; nt < 4; ++nt) *(u32x2*)(orow + 16 * nt + 4 * fq) = (u32x2){pk2(o[nt][0] * inv, o[nt][1] * inv), pk2(o[nt][2] * inv, o[nt][3] * inv)};
    if (fq == 0) (dry ? (float*)ws + 65536 + tid : LSE + tok * 24 + a.g * 8 + a.h)[0] = mx + __logf(ls);
}
__device__ __forceinline__ void attn_phase(KArgs kp, LAS unsigned char* lds, int G, bool dry = false) {
    const Args A = load_args(kp);
    unsigned char* ws = A.ws; OPQ(ws);
    const int tid = opq_tid();
    bf16* Z = (bf16*)(ws + WS_Z); float* LSE = (float*)(ws + WS_LSE);
    constexpr int N_ATT = 6144;
    if (tid < 128) { const int row = 256 + (tid >> 3), ch = tid & 7; unsigned z = 0u; asm volatile("" : "+v"(z)); *(LAS u32x4*)((LAS bf16*)(lds + AT_V) + row * AT_LD + 8 * ch) = (u32x4){z, z, z, z}; }
    u32x4 pr[11]; int ppos;
    int it = blockIdx.x;
    AttnId cur = attn_decode(it < N_ATT ? it : 0);
    if (it < N_ATT) attn_issue(Z, A.pos, cur, tid, pr, ppos);
    for (; it < N_ATT; it += G) {
        attn_commit(lds, tid, pr, ppos);
        __syncthreads();
        const int nx = it + G;
        const AttnId nxt = attn_decode(nx < N_ATT ? nx : 0);
        if (nx < N_ATT) attn_issue(Z, A.pos, nxt, tid, pr, ppos);
        attn_compute(Z, LSE, cur, lds, tid, dry, ws);
        __syncthreads();
        cur = nxt;
    }
}

constexpr int ML_KLD = 264, ML_VLD = 48, ML_CLD = 264;
constexpr int ML_K = 0, ML_V = ML_K + 128 * ML_KLD * 2, ML_VW = ML_V + 128 * ML_VLD * 2, ML_C = ML_VW + 128 * ML_VLD * 2, ML_S = ML_C + 48 * ML_CLD * 2, ML_SBUF = 6 * 128 * 4, ML_G = ML_S + 2 * ML_SBUF, ML_END = ML_G + 4096 * 8;
static_assert(ML_END <= LDS_BYTES - 64, "mlstm LDS");
__device__ __forceinline__ float mlstm_scalars(LAS float* sb, float ig0, float ig1, float f0, float f1, float mcar, int lane) {
    const float lf0 = fminf(f0, 0.f) - log1pf(__expf(-fabsf(f0))), lf1 = fminf(f1, 0.f) - log1pf(__expf(-fabsf(f1)));
    const float pr = lf0 + lf1; float inc = pr;
#pragma unroll
    for (int o = 1; o < 64; o <<= 1) { const float t = __shfl_up(inc, o); if (lane >= o) inc += t; }
    const float b0 = inc - pr + lf0, b1 = inc;
    const float u0 = ig0 - b0, u1 = ig1 - b1;
    float pmx = fmaxf(u0, u1);
#pragma unroll
    for (int o = 1; o < 64; o <<= 1) { const float t = __shfl_up(pmx, o); if (lane >= o) pmx = fmaxf(pmx, t); }
    float ex = __shfl_up(pmx, 1); if (lane == 0) ex = -INFINITY;
    const float pm0 = fmaxf(ex, u0), pm1 = pmx;
    const float mt0 = b0 + fmaxf(mcar, pm0), mt1 = b1 + fmaxf(mcar, pm1);
    const float gtot = __shfl(b1, 63), pmall = __shfl(pm1, 63);
    const float mnew = fmaxf(gtot + mcar, gtot + pmall);
    sb[2 * lane] = b0; sb[2 * lane + 1] = b1; sb[128 + 2 * lane] = u0; sb[128 + 2 * lane + 1] = u1; sb[256 + 2 * lane] = mt0; sb[256 + 2 * lane + 1] = mt1;
    sb[384 + 2 * lane] = __expf(b0 + mcar - mt0); sb[384 + 2 * lane + 1] = __expf(b1 + mcar - mt1);
    sb[512 + 2 * lane] = __expf(gtot + u0 - mnew); sb[512 + 2 * lane + 1] = __expf(gtot + u1 - mnew);
    if (lane == 0) sb[640] = __expf(gtot + mcar - mnew);
    return mnew;
}
__device__ __forceinline__ void mlstm_unit(KArgs kp, int l, int u, LAS unsigned char* lds, bool dry = false) {
    const Args A = load_args(kp);
    unsigned char* ws = A.ws; OPQ(ws); OPQ(l);
    const int tid = opq_tid(), lane = tid & 63, w = tid >> 6, fr = lane & 15, fq = lane >> 4;
    const int b = u >> 5, h = (u >> 3) & 3, js = u & 7;
    bf16* Z = (bf16*)(ws + WS_Z); const bf16* QKC = (const bf16*)(ws + WS_XB); const float* GT = (const float*)(ws + WS_GATES);
    LAS bf16* Ks = (LAS bf16*)(lds + ML_K); LAS bf16* Vs = (LAS bf16*)(lds + ML_V); LAS bf16* Vw = (LAS bf16*)(lds + ML_VW); LAS bf16* CsT = (LAS bf16*)(lds + ML_C);
    const float bi = A.b_igate[l * 4 + h], bfg = A.b_fgate[l * 4 + h];
    f32x4 st[2][3];
#pragma unroll
    for (int a = 0; a < 2; ++a)
#pragma unroll
        for (int c = 0; c < 3; ++c) st[a][c] = (f32x4){0.f, 0.f, 0.f, 0.f};
    float mcar = -INFINITY;
    const size_t tb = (size_t)b * SEQ;
    const int vs = tid >> 2, vch = tid & 3;
    u32x4 kreg[8]; u32x4 vraw; bf16x8 qf[8], qn[8];
    LAS f32x2_t* gl = (LAS f32x2_t*)(lds + ML_G);
    {   float ga[8], gb[8];
#pragma unroll
        for (int k = 0; k < 8; ++k) { const float* gp = GT + (tb + tid + 512 * k) * 8; ga[k] = gp[h]; gb[k] = gp[4 + h]; }
#pragma unroll
        for (int k = 0; k < 8; ++k) gl[tid + 512 * k] = (f32x2_t){ga[k] + bi, gb[k] + bfg};
    }
#pragma unroll
    for (int k = 0; k < 8; ++k) { const int idx = tid + 512 * k, sr = idx >> 5, ch = idx & 31; kreg[k] = *(const u32x4*)(QKC + (tb + sr) * 2048 + 1024 + h * 256 + 8 * ch); }
    vraw = *(const u32x4*)(Z + (tb + vs) * NZ + Z_MV + h * 256 + 32 * js + 8 * vch);
    { const bf16* qp = QKC + (tb + 16 * w + fr) * 2048 + h * 256 + 8 * fq;
#pragma unroll
      for (int ks = 0; ks < 8; ++ks) qf[ks] = __builtin_bit_cast(bf16x8, *(const u32x4*)(qp + 32 * ks)); }
#pragma unroll
    for (int ks = 0; ks < 8; ++ks) qn[ks] = qf[ks];
    __syncthreads();
    if (w == 0) { const f32x2_t g0 = gl[2 * lane], g1 = gl[2 * lane + 1]; mcar = mlstm_scalars((LAS float*)(lds + ML_S), g0.x, g1.x, g0.y, g1.y, mcar, lane); }
    __syncthreads();
#pragma unroll 1
    for (int c = 0; c < 32; ++c) {
        const size_t t0 = tb + (size_t)c * 128, t1 = t0 + 128;
        const bool more = c < 31;
        LAS float* sb = (LAS float*)(lds + ML_S + (c & 1) * ML_SBUF); LAS float* sbn = (LAS float*)(lds + ML_S + ((c + 1) & 1) * ML_SBUF);
#pragma unroll
        for (int k = 0; k < 8; ++k) { const int idx = tid + 512 * k, sr = idx >> 5, ch = idx & 31; *(LAS u32x4*)(Ks + sr * ML_KLD + 8 * ch) = kreg[k]; }
        *(LAS u32x4*)(Vs + vs * ML_VLD + 8 * vch) = vraw;
        {   const float wt = sb[512 + vs]; float f[8]; UNPACK8(vraw, f);
#pragma unroll
            for (int e = 0; e < 8; ++e) f[e] *= wt;
            *(LAS u32x4*)(Vw + vs * ML_VLD + 8 * vch) = PACK8(f); }
        if (tid < 256) { const int sr = tid >> 1, ch = 4 + (tid & 1);
            *(LAS u32x4*)(Vs + sr * ML_VLD + 8 * ch) = (u32x4){(ch == 4) ? 0x3f80u : 0u, 0u, 0u, 0u};
            *(LAS u32x4*)(Vw + sr * ML_VLD + 8 * ch) = (u32x4){(ch == 4) ? f2bf(sb[512 + sr]) : 0u, 0u, 0u, 0u}; }
        __syncthreads();
        if (more) {
#pragma unroll
            for (int k = 0; k < 8; ++k) { const int idx = tid + 512 * k, sr = idx >> 5, ch = idx & 31; kreg[k] = *(const u32x4*)(QKC + (t1 + sr) * 2048 + 1024 + h * 256 + 8 * ch); }
            vraw = *(const u32x4*)(Z + (t1 + vs) * NZ + Z_MV + h * 256 + 32 * js + 8 * vch);
            const bf16* qp = QKC + (t1 + 16 * w + fr) * 2048 + h * 256 + 8 * fq;
#pragma unroll
            for (int ks = 0; ks < 8; ++ks) qn[ks] = __builtin_bit_cast(bf16x8, *(const u32x4*)(qp + 32 * ks));
        }
        const int tq = 16 * w + fr;
        const float btq = sb[tq], mtq = sb[256 + tq], itr = sb[384 + tq];
        f32x4 num[3], qc[3];
#pragma unroll
        for (int nt = 0; nt < 3; ++nt) { num[nt] = (f32x4){0.f, 0.f, 0.f, 0.f}; qc[nt] = (f32x4){0.f, 0.f, 0.f, 0.f}; }
#pragma unroll 1
        for (int k2 = 0; k2 <= (w >> 1); ++k2) {
            u32x4 pp;
            {   f32x4 a0 = {0.f, 0.f, 0.f, 0.f};
#pragma unroll
                for (int ks = 0; ks < 8; ++ks) a0 = mfma16(frag_kc(Ks, ML_KLD, 32 * k2, 32 * ks, lane), qf[ks], a0);
                const f32x4 us = *(const LAS f32x4*)(sb + 128 + 32 * k2 + 4 * fq);
                const bool diag = (2 * k2 == w);
                float p[4];
#pragma unroll
                for (int j = 0; j < 4; ++j) p[j] = (!diag || 4 * fq + j <= fr) ? a0[j] * __expf(btq + us[j] - mtq) : 0.f;
                pp.x = pk2(p[0], p[1]); pp.y = pk2(p[2], p[3]); }
            if (2 * k2 + 1 <= w) {
                f32x4 a1 = {0.f, 0.f, 0.f, 0.f};
#pragma unroll
                for (int ks = 0; ks < 8; ++ks) a1 = mfma16(frag_kc(Ks, ML_KLD, 32 * k2 + 16, 32 * ks, lane), qf[ks], a1);
                const f32x4 us = *(const LAS f32x4*)(sb + 128 + 32 * k2 + 16 + 4 * fq);
                const bool diag = (2 * k2 + 1 == w);
                float p[4];
#pragma unroll
                for (int j = 0; j < 4; ++j) p[j] = (!diag || 4 * fq + j <= fr) ? a1[j] * __expf(btq + us[j] - mtq) : 0.f;
                pp.z = pk2(p[0], p[1]); pp.w = pk2(p[2], p[3]);
            } else { pp.z = 0u; pp.w = 0u; }
            const bf16x8 pf = __builtin_bit_cast(bf16x8, pp);
#pragma unroll
            for (int nt = 0; nt < 3; ++nt) num[nt] = mfma16(frag_ks_pair(Vs, ML_VLD, 32 * k2, 16 * nt, lane), pf, num[nt]);
        }
        if (more && w == 0) { const f32x2_t g0 = gl[(c + 1) * 128 + 2 * lane], g1 = gl[(c + 1) * 128 + 2 * lane + 1]; mcar = mlstm_scalars(sbn, g0.x, g1.x, g0.y, g1.y, mcar, lane); }
        if (c > 0) {
#pragma unroll
            for (int ks = 0; ks < 8; ++ks)
#pragma unroll
                for (int nt = 0; nt < 3; ++nt) qc[nt] = mfma16(frag_kc(CsT, ML_CLD, 16 * nt, 32 * ks, lane), qf[ks], qc[nt]);
        }
#pragma unroll
        for (int ks = 0; ks < 8; ++ks) qf[ks] = qn[ks];
        {
            const float dd = num[2][0] + itr * qc[2][0]; const float den = __shfl(dd, fr);
            const float inv = 1.f / fmaxf(fabsf(den), __expf(-mtq));
            bf16* hp = dry ? (bf16*)ws + tid * 64 : Z + (t0 + tq) * NZ + Z_MV + h * 256 + 32 * js;
#pragma unroll
            for (int nt = 0; nt < 2; ++nt) *(u32x2*)(hp + 16 * nt + 4 * fq) = (u32x2){pk2((num[nt][0] + itr * qc[nt][0]) * inv, (num[nt][1] + itr * qc[nt][1]) * inv), pk2((num[nt][2] + itr * qc[nt][2]) * inv, (num[nt][3] + itr * qc[nt][3]) * inv)};
        }
        {
            const float dec = sb[640];
#pragma unroll
            for (int a = 0; a < 2; ++a)
#pragma unroll
                for (int nt = 0; nt < 3; ++nt) st[a][nt] = st[a][nt] * dec;
#pragma unroll
            for (int ks = 0; ks < 4; ++ks) {
                bf16x8 bfr[3];
#pragma unroll
                for (int nt = 0; nt < 3; ++nt) bfr[nt] = frag_ks(Vw, ML_VLD, 32 * ks, 16 * nt, lane);
#pragma unroll
                for (int a = 0; a < 2; ++a) { const bf16x8 af = frag_ks(Ks, ML_KLD, 32 * ks, 32 * w + 16 * a, lane);
#pragma unroll
                    for (int nt = 0; nt < 3; ++nt) st[a][nt] = mfma16(af, bfr[nt], st[a][nt]); }
            }
        }
        __syncthreads();
#pragma unroll
        for (int a = 0; a < 2; ++a)
#pragma unroll
            for (int nt = 0; nt < 3; ++nt)
                *(LAS u32x2*)(CsT + (16 * nt + fr) * ML_CLD + 32 * w + 16 * a + 4 * fq) = (u32x2){pk2(st[a][nt][0], st[a][nt][1]), pk2(st[a][nt][2], st[a][nt][3])};
    }
    __syncthreads();
}

__device__ __forceinline__ void finish_phase(KArgs kp, int l, int G) {
    const Args A = load_args(kp);
    unsigned char* ws = A.ws; OPQ(ws); OPQ(l);
    const int tid = opq_tid(), lane = tid & 63, wave = tid >> 6, gw = blockIdx.x * 8 + wave, NGW = G * 8;
    const bf16* Z = (const bf16*)(ws + WS_Z); const float* LSE = (const float*)(ws + WS_LSE); bf16* MIX = (bf16*)(ws + WS_XB);
    float hg[16];
#pragma unroll
    for (int e = 0; e < 16; ++e) hg[e] = A.head_norm_g[l * 1024 + 16 * lane + e];
    for (int m = gw; m < M; m += NGW) {
        const bf16* zr = Z + (size_t)m * NZ; bf16* mr = MIX + (size_t)m * 2048;
        {
            const int hh = lane >> 3; const float* lp = LSE + (size_t)m * 24 + hh;
            const float l0 = lp[0], l1 = lp[8], l2 = lp[16], mx = fmaxf(l0, fmaxf(l1, l2));
            float e0 = __expf(l0 - mx), e1 = __expf(l1 - mx), e2 = __expf(l2 - mx); const float inv = 1.f / (e0 + e1 + e2); e0 *= inv; e1 *= inv; e2 *= inv;
            const u32x4 r0 = *(const u32x4*)(zr + Z_AQ + 8 * lane), r1 = *(const u32x4*)(zr + Z_AQ + 512 + 8 * lane), r2 = *(const u32x4*)(zr + Z_AQ + 1024 + 8 * lane), rg = *(const u32x4*)(zr + Z_AG + 8 * lane);
            float o0[8], o1[8], o2[8], gg[8], y[8]; UNPACK8(r0, o0); UNPACK8(r1, o1); UNPACK8(r2, o2); UNPACK8(rg, gg);
#pragma unroll
            for (int e = 0; e < 8; ++e) y[e] = (e0 * o0[e] + e1 * o1[e] + e2 * o2[e]) * silu_f(gg[e]);
            *(u32x4*)(mr + 8 * lane) = PACK8(y);
        }
        *(u32x4*)(mr + 512 + 8 * lane) = *(const u32x4*)(zr + Z_SU + 8 * lane);
        {
            float x[16], gm[16];
#pragma unroll
            for (int c2 = 0; c2 < 2; ++c2) { const u32x4 hv = *(const u32x4*)(zr + Z_MV + 16 * lane + 8 * c2), ov = *(const u32x4*)(zr + Z_MO + 16 * lane + 8 * c2), gv = *(const u32x4*)(zr + Z_MG + 16 * lane + 8 * c2);
                float hf[8], of[8], gf[8]; UNPACK8(hv, hf); UNPACK8(ov, of); UNPACK8(gv, gf);
#pragma unroll
                for (int e = 0; e < 8; ++e) { x[8 * c2 + e] = hf[e] * sigmoid_f(of[e]); gm[8 * c2 + e] = gf[e]; } }
            float s = 0.f;
#pragma unroll
            for (int e = 0; e < 16; ++e) s += x[e];
            const float mean = sum16(s) * (1.f / 256.f); float q = 0.f;
#pragma unroll
            for (int e = 0; e < 16; ++e) { x[e] -= mean; q += x[e] * x[e]; }
            const float rstd = rsqrtf(sum16(q) * (1.f / 256.f) + LN_EPS);
            float y0[8], y1[8];
#pragma unroll
            for (int e = 0; e < 8; ++e) { y0[e] = x[e] * rstd * hg[e] * silu_f(gm[e]); y1[e] = x[8 + e] * rstd * hg[8 + e] * silu_f(gm[8 + e]); }
            *(u32x4*)(mr + 1024 + 16 * lane) = PACK8(y0); *(u32x4*)(mr + 1024 + 16 * lane + 8) = PACK8(y1);
        }
    }
}

__device__ __forceinline__ void ln_phase(KArgs kp, int l, int G, LAS unsigned char* lds) {
    const Args A = load_args(kp);
    unsigned char* ws = A.ws; OPQ(ws); OPQ(l);
    const int tid = opq_tid(), lane = tid & 63, wave = tid >> 6, gw = blockIdx.x * 8 + wave, NGW = G * 8;
    const bool more = (l + 1 < DEPTH);
    LAS f32x4* wg = (LAS f32x4*)lds;
    if (more) { load_gate_w(A.w_in + (size_t)(l + 1) * D * DIN, wg); }
    __syncthreads();
    bf16* XB = (bf16*)(ws + WS_XB); float* GT = (float*)(ws + WS_GATES);
    f32x4 gv[8], bv[8];
#pragma unroll
    for (int i = 0; i < 8; ++i) { gv[i] = *((const f32x4*)(A.ln_g + (size_t)l * D) + lane + 64 * i); bv[i] = *((const f32x4*)(A.ln_b + (size_t)l * D) + lane + 64 * i); }
    for (int m = gw; m < M; m += NGW) {
        f32x4* xr = (f32x4*)(A.out + (size_t)m * D) + lane;
        f32x4 v[8]; float s = 0.f;
#pragma unroll
        for (int i = 0; i < 8; ++i) { v[i] = xr[64 * i]; s += (v[i][0] + v[i][1]) + (v[i][2] + v[i][3]); }
        const float mean = wave_sum(s) * (1.f / D); float q = 0.f;
#pragma unroll
        for (int i = 0; i < 8; ++i) { v[i] = v[i] - mean; q += (v[i][0] * v[i][0] + v[i][1] * v[i][1]) + (v[i][2] * v[i][2] + v[i][3] * v[i][3]); }
        const float rstd = rsqrtf(wave_sum(q) * (1.f / D) + LN_EPS);
#pragma unroll
        for (int i = 0; i < 8; ++i) { v[i] = v[i] * rstd * gv[i] + bv[i]; xr[64 * i] = v[i]; }
        if (more) {
            u32x2* o = (u32x2*)(XB + (size_t)m * D) + lane;
#pragma unroll
            for (int i = 0; i < 8; ++i) o[64 * i] = (u32x2){pk2(v[i][0], v[i][1]), pk2(v[i][2], v[i][3])};
            gate_dots(v, wg, GT + (size_t)m * 8, lane);
        }
    }
    __syncthreads();
}

constexpr size_t WS_BAR = 512 * 1024;
constexpr int LDS_MISC = LDS_BYTES - 64;
#define XB_TMO      128
#define XB_XCNT(j)  (256  + 64 * (j))
#define XB_XSUB(j)  (1280 + 64 * (j))
#define XB_XGEN(j)  (2304 + 64 * (j))
#define XB_TOP      3328
#define XB_TOPGEN   3392
#define XCD_BAR_WORDS 3456
#define XB_SPIN_CAP (1u << 18)

__device__ __forceinline__ unsigned xb_ld(unsigned* p)              { return __hip_atomic_load(p, __ATOMIC_RELAXED, __HIP_MEMORY_SCOPE_AGENT); }
__device__ __forceinline__ unsigned xb_add(unsigned* p, unsigned v) { return __hip_atomic_fetch_add(p, v, __ATOMIC_RELAXED, __HIP_MEMORY_SCOPE_AGENT); }
__device__ __forceinline__ unsigned xb_xcc_id() { return (unsigned)__builtin_amdgcn_s_getreg((3 << 11) | 20) & 0xFu; }
#define XB_SPIN(cond, bar) do { unsigned _sp = 0; while (cond) { __builtin_amdgcn_s_sleep(1); \
    if ((++_sp & 255u) == 0u) { if (xb_ld(&(bar)[XB_TMO])) break; if (_sp > XB_SPIN_CAP) { atomicAdd(&(bar)[XB_TMO], 1u); break; } } } } while (0)

struct XcdBarrier {
    unsigned* bar; unsigned x;
    volatile LAS unsigned* st;
};

__device__ __forceinline__ XcdBarrier xcd_barrier_post(unsigned* bar, volatile LAS unsigned* st) {
    XcdBarrier b; b.bar = bar; b.x = xb_xcc_id(); b.st = st;
    if (threadIdx.x == 0) (void)xb_add(&bar[XB_XCNT(b.x)], 1u);
    return b;
}
__device__ __forceinline__ void xcd_barrier_complete(unsigned* bar, unsigned x, unsigned& nloc, unsigned& nx) {
    const unsigned G = gridDim.x * gridDim.y * gridDim.z;
    unsigned sum, cnt, mine, sp = 0u;
    for (;;) {
        sum = 0u; cnt = 0u; mine = 0u;
#pragma unroll
        for (unsigned j = 0; j < 16; ++j) { const unsigned c = xb_ld(&bar[XB_XCNT(j)]); sum += c; cnt += (c > 0u) ? 1u : 0u; mine = (j == x) ? c : mine; }
        if (sum == G) break;
        __builtin_amdgcn_s_sleep(1);
        if ((++sp & 255u) == 0u) { if (xb_ld(&bar[XB_TMO])) break; if (sp > XB_SPIN_CAP) { atomicAdd(&bar[XB_TMO], 1u); break; } }
    }
    nloc = mine > 0u ? mine : 1u; nx = cnt > 0u ? cnt : 1u;
}

__device__ __forceinline__ void xcd_barrier(const XcdBarrier& b) {
    asm volatile("s_waitcnt vmcnt(0)" ::: "memory");
    __syncthreads();
    if (threadIdx.x == 0) {
        unsigned* bar = b.bar;
        __builtin_amdgcn_s_waitcnt(0);
        unsigned nloc = b.st[0], nx = b.st[1];
        if (nloc == 0u) { xcd_barrier_complete(bar, b.x, nloc, nx); b.st[0] = nloc; b.st[1] = nx; }
        const unsigned old = xb_add(&bar[XB_XSUB(b.x)], 1u);
        const unsigned gen = old / nloc;
        if (old + 1u == (gen + 1u) * nloc) {
            __builtin_amdgcn_fence(__ATOMIC_RELEASE, "agent");
            asm volatile("s_waitcnt vmcnt(0)" ::: "memory");
            const unsigned og = xb_add(&bar[XB_TOP], 1u);
            const unsigned tg = og / nx;
            if (og + 1u == (tg + 1u) * nx) xb_add(&bar[XB_TOPGEN], 1u);
            else XB_SPIN(xb_ld(&bar[XB_TOPGEN]) == tg, bar);
            __builtin_amdgcn_fence(__ATOMIC_ACQUIRE, "agent");
            xb_add(&bar[XB_XGEN(b.x)], 1u);
            asm volatile("s_waitcnt vmcnt(0)" ::: "memory");
        } else {
            XB_SPIN(xb_ld(&bar[XB_XGEN(b.x)]) == gen, bar);
            __builtin_amdgcn_fence(__ATOMIC_ACQUIRE, "agent");
            asm volatile("s_waitcnt vmcnt(0)" ::: "memory");
        }
    }
    __syncthreads();
}


__global__ void __launch_bounds__(512, 2) fwd_megakernel(Args A_unused) {
    const KArgs kp = (KArgs)__builtin_amdgcn_kernarg_segment_ptr();
    extern __shared__ __attribute__((aligned(16))) unsigned char lds_raw[];
    LAS unsigned char* lds = (LAS unsigned char*)lds_raw;
    cg::grid_group grid = cg::this_grid();
    const int G = gridDim.x, bid = blockIdx.x;
    if (threadIdx.x < 16) ((LAS unsigned*)(lds + LDS_MISC))[threadIdx.x] = 0u;
    __syncthreads();
    XcdBarrier xbar;
    { const Args A0 = load_args(kp); xbar = xcd_barrier_post((unsigned*)(A0.ws + WS_BAR), (volatile LAS unsigned*)(lds + LDS_MISC)); }
#define GRID_SYNC() xcd_barrier(xbar)
#ifndef NO_P0
    p0_prologue(kp, lds, G);
#endif
#ifdef PROBE_P0
    GRID_SYNC(); p0_prologue(kp, lds, G);
#endif
    grid.sync();
#pragma unroll
    for (int l = 0; l < DEPTH; ++l) {
        {
            const Args A = load_args(kp);
            pg8::Gemm g{(const pg8::bf16_t*)(A.ws + WS_XB), (const pg8::bf16_t*)(A.ws + WS_WIN + l * WIN_BYTES), M, NZ, D};
            pg8::StaticOrder S; S.init(M, NZ, G, bid);
            pg8::EpiBf16<0> E{(pg8::bf16_t*)(A.ws + WS_Z), NZ, nullptr, 0, 0, 1.f};
#ifndef NO_G1
            pg8::gemm_phase<pg8::EpiBf16<0>, pg8::StaticOrder, true, true>(lds, g, S, E);
#endif
#ifdef PROBE_G1
            GRID_SYNC(); pg8::gemm_phase<pg8::EpiBf16<0>, pg8::StaticOrder, true, true>(lds, g, S, E);
#endif
        }
        GRID_SYNC();
#ifdef PROBE_P2
        {   attn_phase(kp, lds, G, true);
            constexpr int N_SGU = 256, N_CONV = 1024;
            for (int it = bid; it < N_SGU + N_CONV; it += G) {
                if (it < N_SGU) sgu_unit(kp, l, it, lds, true);
                if (it >= N_SGU) conv_unit(kp, l, it - N_SGU);
            }
        }
        GRID_SYNC();
#endif
#ifdef PROBE_SGU
        for (int it = bid; it < 256; it += G) sgu_unit(kp, l, it, lds, true);
        GRID_SYNC();
#endif
#ifdef PROBE_CONV
        for (int it = bid; it < 1024; it += G) conv_unit(kp, l, it);
        GRID_SYNC();
#endif
#ifdef PROBE_ATT
        attn_phase(kp, lds, G, true);
        GRID_SYNC();
#endif
        {
#ifndef NO_ATT
            attn_phase(kp, lds, G);
#endif
            constexpr int N_SGU = 256, N_CONV = 1024;
            for (int it = bid; it < N_SGU + N_CONV; it += G) {
#ifndef NO_SGU
                if (it < N_SGU) sgu_unit(kp, l, it, lds);
#endif
#ifndef NO_CONV
                if (it >= N_SGU) conv_unit(kp, l, it - N_SGU);
#endif
            }
        }
        GRID_SYNC();
#ifdef PROBE_ML
        for (int it = bid; it < 256; it += G) mlstm_unit(kp, l, it, lds, true);
        GRID_SYNC();
#endif
#ifndef NO_ML
        for (int it = bid; it < 256; it += G) mlstm_unit(kp, l, it, lds);
#endif
        GRID_SYNC();
#ifndef NO_FIN
        finish_phase(kp, l, G);
#endif
#ifdef PROBE_FIN
        GRID_SYNC(); finish_phase(kp, l, G);
#endif
        GRID_SYNC();
        {
            const Args A = load_args(kp);
            pg8::Gemm g{(const pg8::bf16_t*)(A.ws + WS_XB), (const pg8::bf16_t*)(A.ws + WS_WOUT + l * WOUT_BYTES), M, D, D};
            pg8::StaticOrder S; S.init(M, D, G, bid);
            pg8::EpiResF32 E{l == 0 ? A.x : (const float*)A.out, A.out, D, 1.41421356237f};
#ifndef NO_G2
            pg8::gemm_phase<pg8::EpiResF32, pg8::StaticOrder, true, true>(lds, g, S, E);
#endif
#ifdef PROBE_G2
            if (l == 0) { GRID_SYNC(); pg8::gemm_phase<pg8::EpiResF32, pg8::StaticOrder, true, true>(lds, g, S, E); }
#endif
        }
        GRID_SYNC();
#ifdef PROBE_SYNC
        for (int i = 0; i < 10; ++i) GRID_SYNC();
#endif
#ifndef NO_LN
        ln_phase(kp, l, G, lds);
#endif
        if (l + 1 < DEPTH) GRID_SYNC();
    }
}

extern "C" void kernel_launch(void* const* d_in, const int* in_sizes, int n_in, void* d_out, int out_size, void* d_ws, size_t ws_size, hipStream_t stream) {
    static int grid = 0;
    if (grid == 0) {
        if (n_in != 15 || out_size != M * D || ws_size < WS_END) { fprintf(stderr, "kernel_launch: unexpected shapes (n_in %d out %d ws %zu need %zu)\n", n_in, out_size, ws_size, (size_t)WS_END); grid = -1; return; }
        int dev = 0, cus = 0, per_cu = 0;
        (void)hipGetDevice(&dev);
        (void)hipDeviceGetAttribute(&cus, hipDeviceAttributeMultiprocessorCount, dev);
        (void)hipFuncSetAttribute((const void*)fwd_megakernel, hipFuncAttributeMaxDynamicSharedMemorySize, LDS_BYTES);
        (void)hipOccupancyMaxActiveBlocksPerMultiprocessor(&per_cu, (const void*)fwd_megakernel, 512, LDS_BYTES);
        if (per_cu < 1) per_cu = 1;
        grid = cus * per_cu;
    }
    if (grid < 0) return;
    Args a{};
    a.x = (const float*)d_in[0]; a.pos = (const int*)d_in[1]; a.w_in = (const float*)d_in[2]; a.sgu_ln_g = (const float*)d_in[3]; a.sgu_ln_b = (const float*)d_in[4];
    a.w_spatial = (const float*)d_in[5]; a.b_spatial = (const float*)d_in[6]; a.conv_w = (const float*)d_in[7]; a.conv_b = (const float*)d_in[8];
    a.b_igate = (const float*)d_in[9]; a.b_fgate = (const float*)d_in[10]; a.head_norm_g = (const float*)d_in[11]; a.w_out = (const float*)d_in[12];
    a.ln_g = (const float*)d_in[13]; a.ln_b = (const float*)d_in[14]; a.out = (float*)d_out; a.ws = (unsigned char*)d_ws;
    (void)hipMemsetAsync((unsigned char*)d_ws + WS_BAR, 0, XCD_BAR_WORDS * 4, stream);
    void* args[] = {&a};
    hipError_t e = hipLaunchCooperativeKernel((void*)fwd_megakernel, dim3(grid), dim3(512), args, LDS_BYTES, stream);
    if (e != hipSuccess) fprintf(stderr, "cooperative launch failed: %s (grid %d)\n", hipGetErrorString(e), grid);
}
```

```cpp
#include <hip/hip_runtime.h>
#include <hip/hip_cooperative_groups.h>
#include <cstdio>
#include <cstdint>
namespace cg = cooperative_groups;
namespace pg8 {
#define PG8_LAS __attribute__((address_space(3)))
typedef unsigned short bf16_t;
typedef short bf16x8 __attribute__((ext_vector_type(8)));
typedef float f32x4 __attribute__((ext_vector_type(4)));
typedef unsigned u32x4 __attribute__((ext_vector_type(4)));
constexpr int BM = 256, BK = 64, HALF = 128, HTB = HALF * BK * 2  , STAGE_BYTES = 8 * HTB, NXCD = 8, WGM = 8;

__host__ __device__ __forceinline__ int lds_byte(int r, int c) { const int st = (r >> 4) * 2 + (c >> 5), rr = r & 15, cc = c & 31, ob = rr * 64 + cc * 2; return st * 1024 + (ob ^ (((ob >> 9) & 1) << 5)); }
__host__ __device__ __forceinline__ void stage_rc(int b, int& R, int& C) { const int st = b / 1024, sb = b % 1024, swz = sb ^ (((sb >> 9) & 1) << 5); R = (st >> 1) * 16 + swz / 64; C = (st & 1) * 32 + (swz % 64) / 2; }
__host__ __device__ __forceinline__ int perm32(int rho) { const int n = rho >> 4, i = rho & 15; return 8 * (i >> 2) + 4 * n + (i & 3); }

struct Unit { int pm, pn; };
struct Gemm { const bf16_t* A; const bf16_t* Bt; int M, N, K; };

struct StaticOrder {
    int nM, nN, nwg, G, c;
    __host__ __device__ void init(int M, int N, int G_, int c_) { nM = M / BM; nN = N / BM; nwg = nM * nN; G = G_; c = c_; }
    __host__ __device__ bool next(int i, Unit& u) const {
        const long L = (long)i * G + c; if (L >= nwg) return false;
        int wgid = (int)L; { const int q = nwg / NXCD, r = nwg % NXCD, xcd = wgid % NXCD, off = wgid / NXCD; wgid = (xcd < r ? xcd * (q + 1) : r * (q + 1) + (xcd - r) * q) + off; }
        const int nig = WGM * nN, gid = wgid / nig, fm = gid * WGM, gsz = (nM - fm) < WGM ? (nM - fm) : WGM;
        u.pm = fm + ((wgid % nig) % gsz); u.pn = (wgid % nig) / gsz; return true;
    }
    __device__ __forceinline__ void a_ready(const Unit&) const {}
    __device__ __forceinline__ void done(const Unit&) const {}
};

__device__ __forceinline__ unsigned cvt_pk_bf16(float lo, float hi) { unsigned r; asm volatile("v_cvt_pk_bf16_f32 %0, %1, %2" : "=v"(r) : "v"(lo), "v"(hi)); return r; }
typedef float f32x2 __attribute__((ext_vector_type(2)));
__device__ __forceinline__ f32x2 gelu_pk(f32x2 v) {
    const f32x2 av = __builtin_elementwise_abs(v), d = av * 0.2316418882f + 1.0f;
    f32x2 t; t.x = __builtin_amdgcn_rcpf(d.x); t.y = __builtin_amdgcn_rcpf(d.y);
    f32x2 q = t * 0.5307027145f + (-0.7265760135f); q = q * t + 0.7107068705f; q = q * t + (-0.142248368f); q = q * t + 0.127414796f; q = q * t;
    const f32x2 s = (v * v) * (-0.72134752044f);
    f32x2 e; e.x = __builtin_amdgcn_exp2f(s.x); e.y = __builtin_amdgcn_exp2f(s.y);
    const f32x2 m = v * (q * e), r = v - m;
    f32x2 o; o.x = v.x < 0.f ? m.x : r.x; o.y = v.y < 0.f ? m.y : r.y; return o;
}

template <int ACT  > struct EpiBf16 {
    static constexpr bool PERM = true, AFTER_DRAIN = false; static_assert(ACT == 0 || ACT == 1, "EpiBf16: ACT is 0 (none) or 1 (gelu_pk)");
    bf16_t* O; int ldc; const float* bias; int split_cols; size_t split_stride; float scale0;
    __device__ __forceinline__ void operator()(const f32x4 (&acc)[2][2][4][2], const Unit& u, int wr, int wc, int fr, int fq) const {
        const int row0 = u.pm * BM + wr * 64 + fr; int colt = u.pn * BM; bf16_t* base = O;
        float sc = 1.f; if (split_cols) { const int t = colt / split_cols; base += (size_t)t * split_stride; colt -= t * split_cols; if (t == 0) sc = scale0; }
        const int col0 = colt + wc * 32 + 8 * fq, bcol0 = u.pn * BM + wc * 32 + 8 * fq;
        f32x4 bv[2][2];
#pragma unroll
        for (int bj = 0; bj < 2; ++bj)
#pragma unroll
            for (int n = 0; n < 2; ++n) bv[bj][n] = bias ? *(const f32x4*)(bias + bcol0 + bj * HALF + 4 * n) : (f32x4){0.f, 0.f, 0.f, 0.f};
#pragma unroll
        for (int ai = 0; ai < 2; ++ai)
#pragma unroll
            for (int m = 0; m < 4; ++m) { bf16_t* rowp = base + (size_t)(row0 + ai * HALF + m * 16) * ldc + col0;
#pragma unroll
                for (int bj = 0; bj < 2; ++bj) { f32x4 v0 = acc[ai][bj][m][0] + bv[bj][0], v1 = acc[ai][bj][m][1] + bv[bj][1];
                    if (ACT == 1) { f32x2 a = gelu_pk((f32x2){v0[0], v0[1]}), b = gelu_pk((f32x2){v0[2], v0[3]}), c = gelu_pk((f32x2){v1[0], v1[1]}), d = gelu_pk((f32x2){v1[2], v1[3]});
                        v0 = (f32x4){a.x, a.y, b.x, b.y}; v1 = (f32x4){c.x, c.y, d.x, d.y}; }
                    v0 = v0 * sc; v1 = v1 * sc; u32x4 w; w.x = cvt_pk_bf16(v0[0], v0[1]); w.y = cvt_pk_bf16(v0[2], v0[3]); w.z = cvt_pk_bf16(v1[0], v1[1]); w.w = cvt_pk_bf16(v1[2], v1[3]);
                    *(u32x4*)(rowp + bj * HALF) = w; } }
    }
};
struct EpiResF32 {
    static constexpr bool PERM = true, AFTER_DRAIN = false;
    const float* R; float* O; int ldc; float alpha;
    __device__ __forceinline__ void operator()(const f32x4 (&acc)[2][2][4][2], const Unit& u, int wr, int wc, int fr, int fq) const {
        const int row0 = u.pm * BM + wr * 64 + fr, col0 = u.pn * BM + wc * 32 + 8 * fq;
#pragma unroll
        for (int ai = 0; ai < 2; ++ai)
#pragma unroll
            for (int m = 0; m < 4; ++m) {
                const size_t ro = (size_t)(row0 + ai * HALF + m * 16) * ldc + col0;
#pragma unroll
                for (int bj = 0; bj < 2; ++bj) {
                    const f32x4 r0 = *(const f32x4*)(R + ro + bj * HALF), r1 = *(const f32x4*)(R + ro + bj * HALF + 4);
                    *(f32x4*)(O + ro + bj * HALF) = r0 * alpha + acc[ai][bj][m][0];
                    *(f32x4*)(O + ro + bj * HALF + 4) = r1 * alpha + acc[ai][bj][m][1];
                }
            }
    }
};
template <class Epi, class Sched, bool ALIGN_EPI = false, bool SP2 = false>
__device__ __forceinline__ void gemm_phase(PG8_LAS unsigned char* lds, const Gemm g, const Sched& S, const Epi& E) {
    int tid_l = threadIdx.x; asm volatile("" : "+v"(tid_l));
    const int tid = tid_l, wid = __builtin_amdgcn_readfirstlane(tid >> 6), lane = tid & 63, wr = wid >> 2, wc = wid & 3, fr = lane & 15, fq = lane >> 4;
    const int K = g.K, nt = K / BK;
    unsigned voffA[2], voffB[2];
#pragma unroll
    for (int i = 0; i < 2; ++i) { int R, C; stage_rc(tid * 16 + i * 8192, R, C); const int Rb = Epi::PERM ? ((R & ~31) + perm32(R & 31)) : R;
        voffA[i] = (unsigned)(R * K + C) * 2u; voffB[i] = (unsigned)(Rb * K + C) * 2u; }
    const size_t kstep = (size_t)(BK * 2);
    const size_t hstep = (size_t)HALF * K * 2;
    const size_t tstep = 2 * hstep;
    const unsigned ldsw = (unsigned)wid * 1024u;
    const int aoff = lds_byte(wr * 64 + fr, fq * 8), boff = lds_byte(wc * 32 + fr, fq * 8);
#define PG8_SA(b, h) (((b) * 2 + (h)) * HTB)
#define PG8_SB(b, h) ((4 + (b) * 2 + (h)) * HTB)
#define PG8_STAGE(bufoff, gbase, voff) do { _Pragma("unroll") for (int _i = 0; _i < 2; ++_i) \
        __builtin_amdgcn_global_load_lds((const unsigned*)((const char*)(gbase) + (voff)[_i]), (PG8_LAS unsigned*)(lds + (bufoff) + ldsw + _i * 8192), 16, 0, 0); } while (0)
#define PG8_LDA(dst, b, h) do { _Pragma("unroll") for (int m = 0; m < 4; ++m) _Pragma("unroll") for (int k = 0; k < 2; ++k) dst[m][k] = *(const PG8_LAS bf16x8*)(lds + PG8_SA(b, h) + aoff + m * 2048 + k * 1024); } while (0)
#define PG8_LDB(dst, b, h) do { _Pragma("unroll") for (int n = 0; n < 2; ++n) _Pragma("unroll") for (int k = 0; k < 2; ++k) dst[n][k] = *(const PG8_LAS bf16x8*)(lds + PG8_SB(b, h) + boff + n * 2048 + k * 1024); } while (0)
#define PG8_MMA(ai, bj, At, Bt) do { __builtin_amdgcn_s_setprio(1); _Pragma("unroll") for (int m = 0; m < 4; ++m) _Pragma("unroll") for (int n = 0; n < 2; ++n) _Pragma("unroll") for (int k = 0; k < 2; ++k) \
        acc[ai][bj][m][n] = __builtin_amdgcn_mfma_f32_16x16x32_bf16(Bt[n][k], At[m][k], acc[ai][bj][m][n], 0, 0, 0); __builtin_amdgcn_s_setprio(0); } while (0)
#define PG8_WAIT_V(n) asm volatile("s_waitcnt vmcnt(" #n ")" ::: "memory")
#define PG8_WAIT_L(n) asm volatile("s_waitcnt lgkmcnt(" #n ")" ::: "memory")
#define PG8_BAR __builtin_amdgcn_s_barrier()
#define PG8_SCHED __builtin_amdgcn_sched_barrier(0)
    Unit cur, nxt; int ui = 0;
    if (!S.next(0, cur)) return;
    f32x4 acc[2][2][4][2];
#pragma unroll
    for (int a = 0; a < 2; ++a)
#pragma unroll
        for (int b = 0; b < 2; ++b)
#pragma unroll
            for (int m = 0; m < 4; ++m)
#pragma unroll
                for (int n = 0; n < 2; ++n) acc[a][b][m][n] = (f32x4){0.f, 0.f, 0.f, 0.f};
    bf16x8 At[4][2], B0[2][2], B1[2][2];
    const char* cA = (const char*)g.A + (size_t)cur.pm * tstep; const char* cB = (const char*)g.Bt + (size_t)cur.pn * tstep;
    S.a_ready(cur);
    if constexpr (SP2) {
        PG8_STAGE(PG8_SB(0, 0), cB, voffB); PG8_STAGE(PG8_SB(0, 1), cB + hstep, voffB); PG8_STAGE(PG8_SA(0, 0), cA, voffA); PG8_STAGE(PG8_SA(0, 1), cA + hstep, voffA);
        if (wr == 1) PG8_BAR;
        PG8_WAIT_V(2); PG8_BAR;
        PG8_STAGE(PG8_SB(1, 0), cB + kstep, voffB); PG8_STAGE(PG8_SA(1, 0), cA + kstep, voffA); PG8_STAGE(PG8_SB(1, 1), cB + hstep + kstep, voffB);
        PG8_WAIT_V(6); PG8_BAR;
    } else {
        PG8_STAGE(PG8_SB(0, 0), cB, voffB); PG8_STAGE(PG8_SA(0, 0), cA, voffA); PG8_STAGE(PG8_SB(0, 1), cB + hstep, voffB); PG8_STAGE(PG8_SA(0, 1), cA + hstep, voffA);
        if (wr == 1) PG8_BAR;
        PG8_WAIT_V(4); PG8_BAR;
        PG8_STAGE(PG8_SB(1, 0), cB + kstep, voffB); PG8_STAGE(PG8_SA(1, 0), cA + kstep, voffA); PG8_STAGE(PG8_SB(1, 1), cB + hstep + kstep, voffB);
        PG8_WAIT_V(6); PG8_BAR;
    }
    for (;;) {
        const bool has_next = S.next(ui + 1, nxt);
        const char* nA = has_next ? (const char*)g.A + (size_t)nxt.pm * tstep : cA; const char* nB = has_next ? (const char*)g.Bt + (size_t)nxt.pn * tstep : cB;
        for (int t = 0; t < nt; t += 2) {
            const bool last = (t == nt - 2);
            const char* a1 = cA + (size_t)(t + 1) * kstep;
            const char* a2 = last ? nA : cA + (size_t)(t + 2) * kstep; const char* b2 = last ? nB : cB + (size_t)(t + 2) * kstep;
            const char* a3 = a2 + kstep; const char* b3 = b2 + kstep;
            if (last && has_next) S.a_ready(nxt);
            if constexpr (SP2) {
            PG8_LDB(B0, 0, 0); PG8_LDB(B1, 0, 1); PG8_SCHED; PG8_LDA(At, 0, 0); PG8_STAGE(PG8_SA(1, 1), a1 + hstep, voffA);
            PG8_WAIT_V(8); PG8_WAIT_L(0); PG8_BAR; PG8_MMA(0, 0, At, B0); PG8_MMA(0, 1, At, B1); PG8_BAR; PG8_SCHED;
            PG8_LDA(At, 0, 1); PG8_STAGE(PG8_SB(0, 0), b2, voffB); PG8_STAGE(PG8_SB(0, 1), b2 + hstep, voffB); PG8_STAGE(PG8_SA(0, 0), a2, voffA);
            PG8_WAIT_V(8); PG8_WAIT_L(0); PG8_BAR; PG8_MMA(1, 0, At, B0); PG8_MMA(1, 1, At, B1); PG8_BAR; PG8_SCHED;
            PG8_LDB(B0, 1, 0); PG8_LDB(B1, 1, 1); PG8_SCHED; PG8_LDA(At, 1, 0); PG8_STAGE(PG8_SA(0, 1), a2 + hstep, voffA);
            PG8_WAIT_V(8); PG8_WAIT_L(0); PG8_BAR; PG8_MMA(0, 0, At, B0); PG8_MMA(0, 1, At, B1); PG8_BAR; PG8_SCHED;
            PG8_LDA(At, 1, 1); PG8_STAGE(PG8_SB(1, 0), b3, voffB); PG8_STAGE(PG8_SB(1, 1), b3 + hstep, voffB); PG8_STAGE(PG8_SA(1, 0), a3, voffA);
            PG8_WAIT_V(8); PG8_WAIT_L(0); PG8_BAR; PG8_MMA(1, 0, At, B0); PG8_MMA(1, 1, At, B1); PG8_BAR; PG8_SCHED;
            } else {
            PG8_LDB(B0, 0, 0); PG8_SCHED; PG8_LDA(At, 0, 0); PG8_STAGE(PG8_SA(1, 1), a1 + hstep, voffA);
            PG8_WAIT_L(8); PG8_BAR; PG8_WAIT_L(0); PG8_MMA(0, 0, At, B0); PG8_BAR; PG8_SCHED;
            PG8_LDB(B1, 0, 1); PG8_STAGE(PG8_SB(0, 0), b2, voffB);
            PG8_BAR; PG8_WAIT_L(0); PG8_MMA(0, 1, At, B1); PG8_BAR;
            PG8_LDA(At, 0, 1); PG8_STAGE(PG8_SA(0, 0), a2, voffA);
            PG8_BAR; PG8_WAIT_L(0); PG8_MMA(1, 0, At, B0); PG8_BAR; PG8_SCHED;
            PG8_STAGE(PG8_SB(0, 1), b2 + hstep, voffB);
            PG8_WAIT_V(6); PG8_BAR; PG8_MMA(1, 1, At, B1); PG8_BAR;
            PG8_LDB(B0, 1, 0); PG8_SCHED; PG8_LDA(At, 1, 0); PG8_STAGE(PG8_SA(0, 1), a2 + hstep, voffA);
            PG8_WAIT_L(8); PG8_BAR; PG8_WAIT_L(0); PG8_MMA(0, 0, At, B0); PG8_BAR; PG8_SCHED;
            PG8_LDB(B1, 1, 1); PG8_STAGE(PG8_SB(1, 0), b3, voffB);
            PG8_BAR; PG8_WAIT_L(0); PG8_MMA(0, 1, At, B1); PG8_BAR;
            PG8_LDA(At, 1, 1); PG8_STAGE(PG8_SA(1, 0), a3, voffA);
            PG8_BAR; PG8_WAIT_L(0); PG8_MMA(1, 0, At, B0); PG8_BAR; PG8_SCHED;
            PG8_STAGE(PG8_SB(1, 1), b3 + hstep, voffB);
            PG8_WAIT_V(6); PG8_BAR; PG8_MMA(1, 1, At, B1); PG8_BAR;
            }
        }
        if constexpr (ALIGN_EPI) { if (wr == 0) PG8_BAR; }
        if constexpr (!Epi::AFTER_DRAIN) { E(acc, cur, wr, wc, fr, fq); S.done(cur); }
        if (!has_next) break;
#pragma unroll
        for (int a = 0; a < 2; ++a)
#pragma unroll
            for (int b = 0; b < 2; ++b)
#pragma unroll
                for (int m = 0; m < 4; ++m)
#pragma unroll
                    for (int n = 0; n < 2; ++n) acc[a][b][m][n] = (f32x4){0.f, 0.f, 0.f, 0.f};
        cur = nxt; cA = nA; cB = nB; ++ui;
        if constexpr (ALIGN_EPI) { if (wr == 1) PG8_BAR; }
    }
    PG8_WAIT_V(0);
    if constexpr (!ALIGN_EPI) { if (wr == 0) PG8_BAR; }
    PG8_BAR;
    if constexpr (Epi::AFTER_DRAIN) { E.fused(acc, cur, wr, wc, fr, fq, lds, wid, lane); S.done(cur); }
#undef PG8_SA
#undef PG8_SB
#undef PG8_STAGE
#undef PG8_LDA
#undef PG8_LDB
#undef PG8_MMA
#undef PG8_WAIT_V
#undef PG8_WAIT_L
#undef PG8_BAR
#undef PG8_SCHED
}
}

constexpr int NB = 8, SEQ = 4096, M = NB * SEQ, D = 2048, DIN = 11784, NZ = 11776, DEPTH = 2;
constexpr int Z_AQ = 0, Z_AK = 1536, Z_AV = 3072, Z_AG = 4608, Z_SU = 5120, Z_SV = 5632, Z_SG = 6144, Z_MQ = 6656, Z_MK = 7680, Z_MV = 8704, Z_MO = 9728, Z_MG = 10752;
constexpr size_t MiB = 1u << 20;
constexpr size_t WIN_BYTES = (size_t)NZ * D * 2, WOUT_BYTES = (size_t)D * D * 2;
constexpr size_t WS_WIN = 1 * MiB, WS_WOUT = WS_WIN + 2 * WIN_BYTES, WS_GATES = WS_WOUT + 2 * WOUT_BYTES, WS_LSE = WS_GATES + (size_t)M * 8 * 4;
constexpr size_t WS_XB = 114 * MiB, WS_Z = WS_XB + (size_t)M * D * 2, WS_END = WS_Z + (size_t)M * NZ * 2;
static_assert(WS_LSE + (size_t)M * 24 * 4 <= WS_XB, "ws map");
constexpr int LDS_BYTES = 159744;
constexpr float LN_EPS = 1e-5f;

typedef unsigned short bf16;
typedef short bf16x8 __attribute__((ext_vector_type(8)));
typedef float f32x4 __attribute__((ext_vector_type(4)));
typedef unsigned u32x4 __attribute__((ext_vector_type(4)));
typedef unsigned u32x2 __attribute__((ext_vector_type(2)));
typedef short s16x4 __attribute__((ext_vector_type(4)));
#define LAS __attribute__((address_space(3)))

struct Args {
    const float* x; const int* pos; const float* w_in; const float* sgu_ln_g; const float* sgu_ln_b; const float* w_spatial; const float* b_spatial;
    const float* conv_w; const float* conv_b; const float* b_igate; const float* b_fgate; const float* head_norm_g; const float* w_out; const float* ln_g; const float* ln_b;
    float* out; unsigned char* ws;
};

__device__ __forceinline__ float bflo(unsigned w) { return __builtin_bit_cast(float, w << 16); }
__device__ __forceinline__ float bfhi(unsigned w) { return __builtin_bit_cast(float, w & 0xffff0000u); }
__device__ __forceinline__ float bf1(bf16 u) { return __builtin_bit_cast(float, (unsigned)u << 16); }
typedef float f32x2_t __attribute__((ext_vector_type(2)));
typedef __bf16 bf16x2_t __attribute__((ext_vector_type(2)));
__device__ __forceinline__ unsigned pk2(float lo, float hi) { const f32x2_t v = {lo, hi}; return __builtin_bit_cast(unsigned, __builtin_convertvector(v, bf16x2_t)); }
__device__ __forceinline__ unsigned f2bf(float f) { return pk2(f, 0.f) & 0xffffu; }
#define UNPACK8(v, f) do { f[0] = bflo(v.x); f[1] = bfhi(v.x); f[2] = bflo(v.y); f[3] = bfhi(v.y); f[4] = bflo(v.z); f[5] = bfhi(v.z); f[6] = bflo(v.w); f[7] = bfhi(v.w); } while (0)
#define PACK8(f) ((u32x4){pk2(f[0], f[1]), pk2(f[2], f[3]), pk2(f[4], f[5]), pk2(f[6], f[7])})
__device__ __forceinline__ float fexp(float x) { return __builtin_amdgcn_exp2f(x * 1.4426950408889634f); }
__device__ __forceinline__ float flog(float x) { return __builtin_amdgcn_logf(x) * 0.6931471805599453f; }
__device__ __forceinline__ float frcp(float x) { return __builtin_amdgcn_rcpf(x); }
__device__ __forceinline__ float frsq(float x) { return __builtin_amdgcn_rsqf(x); }
__device__ __forceinline__ float silu_f(float y) { return y * frcp(1.f + fexp(-y)); }
__device__ __forceinline__ float sigmoid_f(float y) { return frcp(1.f + fexp(-y)); }
__device__ __forceinline__ float gelu_f(float v) {
    const float av = fabsf(v), t = __builtin_amdgcn_rcpf(av * 0.2316418882f + 1.0f);
    float q = t * 0.5307027145f + (-0.7265760135f); q = q * t + 0.7107068705f; q = q * t + (-0.142248368f); q = q * t + 0.127414796f; q = q * t;
    const float e = __builtin_amdgcn_exp2f((v * v) * (-0.72134752044f));
    const float m = v * (q * e);
    return v < 0.f ? m : v - m;
}
__device__ __forceinline__ f32x4 mfma16(bf16x8 a, bf16x8 b, f32x4 c) { return __builtin_amdgcn_mfma_f32_16x16x32_bf16(a, b, c, 0, 0, 0); }
__device__ __forceinline__ bf16x8 frag_kc(const LAS bf16* base, int ld, int r0, int k0, int lane) {
    return *(const LAS bf16x8*)(base + (r0 + (lane & 15)) * ld + k0 + 8 * (lane >> 4));
}
__device__ __forceinline__ s16x4 tr_rd(const LAS bf16* p) { return __builtin_bit_cast(s16x4, __builtin_amdgcn_ds_read_tr16_b64_v4i16((LAS s16x4*)p)); }
__device__ __forceinline__ bf16x8 frag_ks(const LAS bf16* base, int ld, int k0, int r0, int lane) {
    const int g = lane >> 4, q = (lane & 15) >> 2, p = lane & 3;
    const LAS bf16* a = base + (k0 + 8 * g + q) * ld + r0 + 4 * p;
    const s16x4 lo = tr_rd(a), hi = tr_rd(a + 4 * ld);
    return (bf16x8){lo[0], lo[1], lo[2], lo[3], hi[0], hi[1], hi[2], hi[3]};
}
__device__ __forceinline__ float wave_sum(float v) {
#pragma unroll
    for (int o = 1; o < 64; o <<= 1) v += __shfl_xor(v, o);
    return v;
}
__device__ __forceinline__ float sum16(float v) { v += __shfl_xor(v, 1); v += __shfl_xor(v, 2); v += __shfl_xor(v, 4); v += __shfl_xor(v, 8); return v; }
__device__ __forceinline__ float max16(float v) { v = fmaxf(v, __shfl_xor(v, 1)); v = fmaxf(v, __shfl_xor(v, 2)); v = fmaxf(v, __shfl_xor(v, 4)); v = fmaxf(v, __shfl_xor(v, 8)); return v; }
#define LDS_WAIT() asm volatile("s_waitcnt lgkmcnt(0)" ::: "memory")
#define OPQ(x) asm volatile("" : "+s"(x))
typedef const Args __attribute__((address_space(4)))* KArgs;
__device__ __forceinline__ Args load_args(KArgs p) {
#if defined(__HIP_DEVICE_COMPILE__)
    asm volatile("" : "+s"(p)); return *p;
#else
    return Args{};
#endif
}
__device__ __forceinline__ int opq_tid() { int t = threadIdx.x; asm volatile("" : "+v"(t)); return t; }

__device__ __forceinline__ void transpose_item(const float* W, int ldw, int K, bf16* WT, LAS float* scr, int item, int nblk, int lane) {
    const int kb = item / nblk, nb = item % nblk, k0 = 64 * kb, n0 = 32 * nb;
#pragma unroll 8
    for (int i = 0; i < 32; ++i) { const int kk = 2 * i + (lane >> 5); scr[kk * 33 + (lane & 31)] = W[(size_t)(k0 + kk) * ldw + n0 + (lane & 31)]; }
    LDS_WAIT();
    const int c = lane & 7;
#pragma unroll
    for (int j = 0; j < 4; ++j) { const int n = (lane >> 3) + 8 * j; const LAS float* s = scr + (8 * c) * 33 + n;
        u32x4 o; o.x = pk2(s[0 * 33], s[1 * 33]); o.y = pk2(s[2 * 33], s[3 * 33]); o.z = pk2(s[4 * 33], s[5 * 33]); o.w = pk2(s[6 * 33], s[7 * 33]);
        *(u32x4*)(WT + (size_t)(n0 + n) * K + k0 + 8 * c) = o; }
    LDS_WAIT();
}
__device__ __forceinline__ void load_gate_w(const float* w_in_l, LAS f32x4* wg) {
    for (int idx = opq_tid(); idx < 4096; idx += 512) { const int k = idx >> 1, hh = idx & 1, i = k >> 8, ln = (k & 255) >> 2, e = k & 3;
        wg[((i * 4 + e) * 2 + hh) * 64 + ln] = *(const f32x4*)(w_in_l + (size_t)k * DIN + NZ + 4 * hh); }
}
__device__ __forceinline__ void gate_dots(const f32x4 (&v)[8], const LAS f32x4* wg, float* gates, int lane) {
    f32x4 a0 = {0.f, 0.f, 0.f, 0.f}, a1 = {0.f, 0.f, 0.f, 0.f};
#pragma unroll
    for (int i = 0; i < 8; ++i)
#pragma unroll
        for (int e = 0; e < 4; ++e) { const f32x4 w0 = wg[((i * 4 + e) * 2 + 0) * 64 + lane], w1 = wg[((i * 4 + e) * 2 + 1) * 64 + lane]; a0 += w0 * v[i][e]; a1 += w1 * v[i][e];
            if (e == 3) __builtin_amdgcn_sched_barrier(0); }
#pragma unroll
    for (int e = 0; e < 4; ++e) { a0[e] = wave_sum(a0[e]); a1[e] = wave_sum(a1[e]); }
    if (lane == 0) { *(f32x4*)gates = a0; *(f32x4*)(gates + 4) = a1; }
}
__device__ __forceinline__ void p0_prologue(KArgs kp, LAS unsigned char* lds, int G) {
    const Args A = load_args(kp);
    unsigned char* ws = A.ws; OPQ(ws);
    const int tid = opq_tid(), lane = tid & 63, wave = tid >> 6;
    const int gw = blockIdx.x * 8 + wave, NGW = G * 8;
    LAS float* scr = (LAS float*)(lds + wave * 16384);
    constexpr int I_IN = (D / 64) * (NZ / 32), I_OUT = (D / 64) * (D / 32);
    for (int it = gw; it < 2 * (I_IN + I_OUT); it += NGW) {
        int r = it; const int l = r / (I_IN + I_OUT); r -= l * (I_IN + I_OUT);
        if (r < I_IN) transpose_item(A.w_in + (size_t)l * D * DIN, DIN, D, (bf16*)(ws + WS_WIN + l * WIN_BYTES), scr, r, NZ / 32, lane);
        else transpose_item(A.w_out + (size_t)l * D * D, D, D, (bf16*)(ws + WS_WOUT + l * WOUT_BYTES), scr, r - I_IN, D / 32, lane);
    }
    __syncthreads();
    LAS f32x4* wg = (LAS f32x4*)lds;
    load_gate_w(A.w_in, wg);
    __syncthreads();
    bf16* XB = (bf16*)(ws + WS_XB); float* GT = (float*)(ws + WS_GATES);
    for (int m = gw; m < M; m += NGW) {
        const f32x4* xr = (const f32x4*)(A.x + (size_t)m * D) + lane;
        f32x4 v[8];
#pragma unroll
        for (int i = 0; i < 8; ++i) v[i] = xr[64 * i];
        u32x2* o = (u32x2*)(XB + (size_t)m * D) + lane;
#pragma unroll
        for (int i = 0; i < 8; ++i) o[64 * i] = (u32x2){pk2(v[i][0], v[i][1]), pk2(v[i][2], v[i][3])};
        gate_dots(v, wg, GT + (size_t)m * 8, lane);
    }
    __syncthreads();
}

__device__ __forceinline__ void conv_unit(KArgs kp, int l, int u) {
    const Args A = load_args(kp);
    unsigned char* ws = A.ws; OPQ(ws); OPQ(l);
    const int tid = opq_tid(), cgp = tid & 255, half = tid >> 8, c0 = 8 * cgp, r0 = 32 * u + 16 * half;
    const bf16* Z = (const bf16*)(ws + WS_Z); bf16* Q = (bf16*)(ws + WS_XB);
    const float* cw = A.conv_w + (size_t)l * 4 * 2048 + c0; const float* cb = A.conv_b + (size_t)l * 2048 + c0;
    const bf16* zp = Z + (size_t)r0 * NZ + Z_MQ + c0;
    u32x4 rows[19];
    const bool hist = (r0 & (SEQ - 1)) != 0;
#pragma unroll
    for (int t = 0; t < 3; ++t) { rows[t] = (u32x4){0u, 0u, 0u, 0u}; if (hist) rows[t] = *(const u32x4*)(zp + (size_t)(t - 3) * NZ); }
#pragma unroll
    for (int t = 0; t < 16; ++t) rows[3 + t] = *(const u32x4*)(zp + (size_t)t * NZ);
    float w0[8], w1[8], w2[8], w3[8], bb[8], x3[8], x2[8], x1[8], cur[8], y[8];
#pragma unroll
    for (int e = 0; e < 8; ++e) { w0[e] = cw[e]; w1[e] = cw[2048 + e]; w2[e] = cw[4096 + e]; w3[e] = cw[6144 + e]; bb[e] = cb[e]; }
    UNPACK8(rows[0], x3); UNPACK8(rows[1], x2); UNPACK8(rows[2], x1);
    const float sc = (c0 >= 1024) ? 0.0625f : 1.f;
#pragma unroll
    for (int t = 0; t < 16; ++t) {
        UNPACK8(rows[3 + t], cur);
#pragma unroll
        for (int e = 0; e < 8; ++e) { const float sv = bb[e] + w0[e] * x3[e] + w1[e] * x2[e] + w2[e] * x1[e] + w3[e] * cur[e]; y[e] = silu_f(sv) * sc; x3[e] = x2[e]; x2[e] = x1[e]; x1[e] = cur[e]; }
        *(u32x4*)(Q + (size_t)(r0 + t) * 2048 + c0) = PACK8(y);
    }
}

constexpr int SGU_VLD = 520;
__device__ __forceinline__ void sgu_unit(KArgs kp, int l, int u, LAS unsigned char* lds, bool dry = false) {
    const Args A = load_args(kp);
    unsigned char* ws = A.ws; OPQ(ws); OPQ(l);
    const int tid = opq_tid(), lane = tid & 63, w = tid >> 6;
    bf16* Z = (bf16*)(ws + WS_Z);
    LAS bf16* VN = (LAS bf16*)lds;
    const size_t t0 = (size_t)u * 128;
    {
        u32x4 raw[16];
#pragma unroll
        for (int tt = 0; tt < 16; ++tt) raw[tt] = *(const u32x4*)(Z + (t0 + 16 * w + tt) * NZ + Z_SV + 8 * lane);
#pragma unroll
        for (int tt = 0; tt < 16; ++tt) *(LAS u32x4*)(VN + (16 * w + tt) * SGU_VLD + 8 * lane) = raw[tt];
        float g8[8], b8[8];
#pragma unroll
        for (int e = 0; e < 8; ++e) { g8[e] = A.sgu_ln_g[l * 512 + 8 * lane + e]; b8[e] = A.sgu_ln_b[l * 512 + 8 * lane + e]; }
#pragma unroll 1
        for (int tt = 0; tt < 16; ++tt) { const int t = 16 * w + tt;
            const u32x4 rv = *(const LAS u32x4*)(VN + t * SGU_VLD + 8 * lane); float f[8]; UNPACK8(rv, f);
            float sm = 0.f;
#pragma unroll
            for (int e = 0; e < 8; ++e) { f[e] = gelu_f(f[e]); sm += f[e]; }
            const float mean = wave_sum(sm) * (1.f / 512.f); float q = 0.f;
#pragma unroll
            for (int e = 0; e < 8; ++e) { f[e] -= mean; q += f[e] * f[e]; }
            const float rstd = frsq(wave_sum(q) * (1.f / 512.f) + LN_EPS);
#pragma unroll
            for (int e = 0; e < 8; ++e) f[e] = f[e] * rstd * g8[e] + b8[e];
            *(LAS u32x4*)(VN + t * SGU_VLD + 8 * lane) = PACK8(f);
        }
    }
    __syncthreads();
    const int fr = lane & 15, fq = lane >> 4, trow = 16 * w + fr;
    bf16* zr = Z + (t0 + trow) * NZ;
#pragma unroll 1
    for (int g = 0; g < 4; ++g) {
        f32x4 acc[8];
#pragma unroll
        for (int mt = 0; mt < 8; ++mt) acc[mt] = (f32x4){0.f, 0.f, 0.f, 0.f};
        u32x2 su2[8], sg2[8];
#pragma unroll
        for (int mt = 0; mt < 8; ++mt) { su2[mt] = *(const u32x2*)(zr + Z_SU + g * 128 + 16 * mt + 4 * fq); sg2[mt] = *(const u32x2*)(zr + Z_SG + g * 128 + 16 * mt + 4 * fq); }
        const float* wrow = A.w_spatial + (((size_t)l * 4 + g) * 128 + trow) * 128;
        const float bs = A.b_spatial[((size_t)l * 4 + g) * 128 + trow];
        for (int ks = 0; ks <= (w >> 1); ++ks) {
            const int s0 = 32 * ks + 8 * fq;
            const f32x4 wa = *(const f32x4*)(wrow + s0), wb = *(const f32x4*)(wrow + s0 + 4);
            float wf[8] = {wa[0], wa[1], wa[2], wa[3], wb[0], wb[1], wb[2], wb[3]};
#pragma unroll
            for (int e = 0; e < 8; ++e) wf[e] = (s0 + e <= trow) ? wf[e] : 0.f;
            const u32x4 bp = PACK8(wf); const bf16x8 bfrag = __builtin_bit_cast(bf16x8, bp);
#pragma unroll
            for (int mt = 0; mt < 8; ++mt) acc[mt] = mfma16(frag_ks(VN, SGU_VLD, 32 * ks, g * 128 + 16 * mt, lane), bfrag, acc[mt]);
        }
#pragma unroll
        for (int mt = 0; mt < 8; ++mt) {
            const float u0 = gelu_f(bflo(su2[mt].x)), u1 = gelu_f(bfhi(su2[mt].x)), u2 = gelu_f(bflo(su2[mt].y)), u3 = gelu_f(bfhi(su2[mt].y));
            const float g0 = silu_f(bflo(sg2[mt].x)), g1 = silu_f(bfhi(sg2[mt].x)), g2 = silu_f(bflo(sg2[mt].y)), g3 = silu_f(bfhi(sg2[mt].y));
            const u32x2 o = {pk2(u0 * (acc[mt][0] + bs) * g0, u1 * (acc[mt][1] + bs) * g1), pk2(u2 * (acc[mt][2] + bs) * g2, u3 * (acc[mt][3] + bs) * g3)};
            *(u32x2*)(dry ? (bf16*)ws + tid * 64 : zr + Z_SU + g * 128 + 16 * mt + 4 * fq) = o;
        }
    }
    __syncthreads();
}

constexpr int AT_LD = 72, AT_PLD = 168;
constexpr int AT_Q = 0, AT_K = AT_Q + 128 * AT_LD * 2, AT_V = AT_K + 256 * AT_LD * 2, AT_P = AT_V + 272 * AT_LD * 2, AT_END = AT_P + 8 * 16 * AT_PLD * 2;
static_assert(AT_END <= LDS_BYTES, "attention LDS");
struct AttnId { int g, b, h, r, n, d, hc; };
__device__ __forceinline__ AttnId attn_decode(int slot) {
    const int u = (slot & ~63) | ((slot & 7) << 3) | ((slot >> 3) & 7);
    AttnId a; a.g = u >> 11; const int rem = u & 2047; a.b = rem >> 8; a.h = (rem >> 5) & 7; const int rn = rem & 31;
    const int dsh = 2 * a.g, nbsh = 5 - dsh; a.d = 1 << dsh; a.r = rn >> nbsh; a.n = rn & ((1 << nbsh) - 1); a.hc = (a.g * 8 + a.h) * 64; return a;
}
__device__ __forceinline__ void attn_issue(const bf16* Z, const int* posp, const AttnId& a, int tid, u32x4 (&pr)[11], int& ppos) {
    const size_t tokb = (size_t)a.b * SEQ;
#pragma unroll
    for (int i = 0; i < 11; ++i) pr[i] = (u32x4){0u, 0u, 0u, 0u};
    ppos = 0;
    if (tid < 384) {
        const int isK = tid >= 128, idx = isK ? tid - 128 : tid, isub = isK ? 128 * (a.n - 1) + idx : 128 * a.n + idx;
        if (isub >= 0) { const size_t tok = tokb + (size_t)isub * a.d + a.r; const bf16* src = Z + tok * NZ + (isK ? Z_AK : Z_AQ) + a.hc;
            pr[0] = *(const u32x4*)src; pr[1] = *(const u32x4*)(src + 8); ppos = posp[tok]; }
    }
#pragma unroll
    for (int k = 0; k < 5; ++k) { const int idx = tid + 512 * k;
        if (idx < 2304) { const int row = idx / 6, ch = 2 + idx % 6, isK = row >= 128, ri = isK ? row - 128 : row, isub = isK ? 128 * (a.n - 1) + ri : 128 * a.n + ri;
            if (isub >= 0) pr[2 + k] = *(const u32x4*)(Z + (tokb + (size_t)isub * a.d + a.r) * NZ + (isK ? Z_AK : Z_AQ) + a.hc + 8 * ch); } }
#pragma unroll
    for (int k = 0; k < 4; ++k) { const int idx = tid + 512 * k, row = idx >> 3, ch = idx & 7, isub = 128 * (a.n - 1) + row;
        if (isub >= 0) pr[7 + k] = *(const u32x4*)(Z + (tokb + (size_t)isub * a.d + a.r) * NZ + Z_AV + a.hc + 8 * ch); }
}
__device__ __forceinline__ void attn_commit(LAS unsigned char* lds, int tid, const u32x4 (&pr)[11], int ppos) {
    LAS bf16* Qs = (LAS bf16*)(lds + AT_Q); LAS bf16* Ks = (LAS bf16*)(lds + AT_K); LAS bf16* Vs = (LAS bf16*)(lds + AT_V);
    if (tid < 384) {
        const int isK = tid >= 128, idx = isK ? tid - 128 : tid;
        LAS bf16* dst = (isK ? Ks : Qs) + idx * AT_LD;
        float t1[8], t2[8]; UNPACK8(pr[0], t1); UNPACK8(pr[1], t2);
        const float pos = (float)ppos;
        const float invf[8] = {1.0f, 0.19392274474868576f, 0.03760603093086393f, 0.007292664737217109f, 0.001414213562373095f, 0.0002742481756762073f, 5.318295896944988e-05f, 1.031338537721246e-05f};
#pragma unroll
        for (int i = 0; i < 8; ++i) {
            const float ang = pos * invf[i], k = rintf(ang * 0.15915494309189535f);
            float rr = fmaf(-k, 6.2831854820251465f, ang); rr = fmaf(-k, -1.7484555e-7f, rr);
            const float cs = __cosf(rr), sn = __sinf(rr);
            const float a1 = t1[i] * cs - t2[i] * sn, a2 = t2[i] * cs + t1[i] * sn; t1[i] = a1; t2[i] = a2;
        }
        *(LAS u32x4*)dst = PACK8(t1); *(LAS u32x4*)(dst + 8) = PACK8(t2);
    }
#pragma unroll
    for (int k = 0; k < 5; ++k) { const int idx = tid + 512 * k;
        if (idx < 2304) { const int row = idx / 6, ch = 2 + idx % 6, isK = row >= 128, ri = isK ? row - 128 : row;
            *(LAS u32x4*)((isK ? Ks : Qs) + ri * AT_LD + 8 * ch) = pr[2 + k]; } }
#pragma unroll
    for (int k = 0; k < 4; ++k) { const int idx = tid + 512 * k, row = idx >> 3, ch = idx & 7; *(LAS u32x4*)(Vs + row * AT_LD + 8 * ch) = pr[7 + k]; }
}
__device__ __forceinline__ bf16x8 frag_ks_pair(const LAS bf16* base, int ld, int k0, int r0, int lane) {
    const int g = lane >> 4, q = (lane & 15) >> 2, p = lane & 3;
    const LAS bf16* a = base + (k0 + 4 * g + q) * ld + r0 + 4 * p;
    const s16x4 lo = tr_rd(a), hi = tr_rd(a + 16 * ld);
    return (bf16x8){lo[0], lo[1], lo[2], lo[3], hi[0], hi[1], hi[2], hi[3]};
}
__device__ __forceinline__ void attn_compute(bf16* Z, float* LSE, const AttnId& a, LAS unsigned char* lds, int tid, bool dry, unsigned char* ws) {
    const int lane = tid & 63, w = tid >> 6, fr = lane & 15, fq = lane >> 4, n = a.n;
    LAS bf16* Qs = (LAS bf16*)(lds + AT_Q); LAS bf16* Ks = (LAS bf16*)(lds + AT_K); LAS bf16* Vs = (LAS bf16*)(lds + AT_V);
    const bf16x8 q0 = frag_kc(Qs, AT_LD, 16 * w, 0, lane), q1 = frag_kc(Qs, AT_LD, 16 * w, 32, lane);
    f32x4 s[10];
    float mx = -INFINITY;
#pragma unroll
    for (int tt = 0; tt < 9; ++tt) { const int kt = w + tt;
        f32x4 acc = {0.f, 0.f, 0.f, 0.f};
        acc = mfma16(frag_kc(Ks, AT_LD, 16 * kt, 0, lane), q0, acc); acc = mfma16(frag_kc(Ks, AT_LD, 16 * kt, 32, lane), q1, acc);
        const bool tile_ok = (n > 0) || (kt >= 8);
#pragma unroll
        for (int j = 0; j < 4; ++j) { const int dl = fr - 4 * fq - j; const bool ok = tile_ok && (tt == 0 ? dl <= 0 : (tt == 8 ? dl >= 0 : true));
            acc[j] = ok ? acc[j] * 0.125f : -INFINITY; mx = fmaxf(mx, acc[j]); }
        s[tt] = acc;
    }
    mx = fmaxf(mx, __shfl_xor(mx, 16)); mx = fmaxf(mx, __shfl_xor(mx, 32));
    float ls = 0.f;
#pragma unroll
    for (int tt = 0; tt < 9; ++tt)
#pragma unroll
        for (int j = 0; j < 4; ++j) { const float p = fexp(s[tt][j] - mx); ls += p; s[tt][j] = p; }
    s[9] = (f32x4){0.f, 0.f, 0.f, 0.f};
    ls += __shfl_xor(ls, 16); ls += __shfl_xor(ls, 32);
    f32x4 o[4];
#pragma unroll
    for (int nt = 0; nt < 4; ++nt) o[nt] = (f32x4){0.f, 0.f, 0.f, 0.f};
#pragma unroll
    for (int k2 = 0; k2 < 5; ++k2) {
        const u32x4 pp = {pk2(s[2 * k2][0], s[2 * k2][1]), pk2(s[2 * k2][2], s[2 * k2][3]), pk2(s[2 * k2 + 1][0], s[2 * k2 + 1][1]), pk2(s[2 * k2 + 1][2], s[2 * k2 + 1][3])};
        const bf16x8 pf = __builtin_bit_cast(bf16x8, pp);
#pragma unroll
        for (int nt = 0; nt < 4; ++nt) o[nt] = mfma16(frag_ks_pair(Vs, AT_LD, 16 * (w + 2 * k2), 16 * nt, lane), pf, o[nt]); }
    const int isub = 128 * n + 16 * w + fr; const size_t tok = (size_t)a.b * SEQ + (size_t)isub * a.d + a.r; const float inv = frcp(ls);
    bf16* orow = dry ? (bf16*)ws + tid * 64 : Z + tok * NZ + Z_AQ + a.hc;
#pragma unroll
    for (int nt = 0; nt < 4; ++nt) *(u32x2*)(orow + 16 * nt + 4 * fq) = (u32x2){pk2(o[nt][0] * inv, o[nt][1] * inv), pk2(o[nt][2] * inv, o[nt][3] * inv)};
    if (fq == 0) (dry ? (float*)ws + 65536 + tid : LSE + tok * 24 + a.g * 8 + a.h)[0] = mx + flog(ls);
}
__device__ __forceinline__ void attn_phase(KArgs kp, LAS unsigned char* lds, int G, bool dry = false) {
    const Args A = load_args(kp);
    unsigned char* ws = A.ws; OPQ(ws);
    const int tid = opq_tid();
    bf16* Z = (bf16*)(ws + WS_Z); float* LSE = (float*)(ws + WS_LSE);
    constexpr int N_ATT = 6144;
    if (tid < 128) { const int row = 256 + (tid >> 3), ch = tid & 7; unsigned z = 0u; asm volatile("" : "+v"(z)); *(LAS u32x4*)((LAS bf16*)(lds + AT_V) + row * AT_LD + 8 * ch) = (u32x4){z, z, z, z}; }
    u32x4 pr[11]; int ppos;
    int it = blockIdx.x;
    AttnId cur = attn_decode(it < N_ATT ? it : 0);
    if (it < N_ATT) attn_issue(Z, A.pos, cur, tid, pr, ppos);
    for (; it < N_ATT; it += G) {
        attn_commit(lds, tid, pr, ppos);
        __syncthreads();
        const int nx = it + G;
        const AttnId nxt = attn_decode(nx < N_ATT ? nx : 0);
        if (nx < N_ATT) attn_issue(Z, A.pos, nxt, tid, pr, ppos);
        attn_compute(Z, LSE, cur, lds, tid, dry, ws);
        __syncthreads();
        cur = nxt;
    }
}

constexpr int ML_KLD = 264, ML_VLD = 48, ML_CLD = 264;
constexpr int ML_K = 0, ML_V = ML_K + 128 * ML_KLD * 2, ML_VW = ML_V + 128 * ML_VLD * 2, ML_C = ML_VW + 128 * ML_VLD * 2, ML_S = ML_C + 48 * ML_CLD * 2, ML_SBUF = 6 * 128 * 4, ML_G = ML_S + 2 * ML_SBUF, ML_END = ML_G + 4096 * 8;
static_assert(ML_END <= LDS_BYTES - 64, "mlstm LDS");
__device__ __forceinline__ float mlstm_scalars(LAS float* sb, float ig0, float ig1, float f0, float f1, float mcar, int lane) {
    const float lf0 = fminf(f0, 0.f) - log1pf(fexp(-fabsf(f0))), lf1 = fminf(f1, 0.f) - log1pf(fexp(-fabsf(f1)));
    const float pr = lf0 + lf1; float inc = pr;
#pragma unroll
    for (int o = 1; o < 64; o <<= 1) { const float t = __shfl_up(inc, o); if (lane >= o) inc += t; }
    const float b0 = inc - pr + lf0, b1 = inc;
    const float u0 = ig0 - b0, u1 = ig1 - b1;
    float pmx = fmaxf(u0, u1);
#pragma unroll
    for (int o = 1; o < 64; o <<= 1) { const float t = __shfl_up(pmx, o); if (lane >= o) pmx = fmaxf(pmx, t); }
    float ex = __shfl_up(pmx, 1); if (lane == 0) ex = -INFINITY;
    const float pm0 = fmaxf(ex, u0), pm1 = pmx;
    const float mt0 = b0 + fmaxf(mcar, pm0), mt1 = b1 + fmaxf(mcar, pm1);
    const float gtot = __shfl(b1, 63), pmall = __shfl(pm1, 63);
    const float mnew = fmaxf(gtot + mcar, gtot + pmall);
    sb[2 * lane] = b0; sb[2 * lane + 1] = b1; sb[128 + 2 * lane] = u0; sb[128 + 2 * lane + 1] = u1; sb[256 + 2 * lane] = mt0; sb[256 + 2 * lane + 1] = mt1;
    sb[384 + 2 * lane] = fexp(b0 + mcar - mt0); sb[384 + 2 * lane + 1] = fexp(b1 + mcar - mt1);
    sb[512 + 2 * lane] = fexp(gtot + u0 - mnew); sb[512 + 2 * lane + 1] = fexp(gtot + u1 - mnew);
    if (lane == 0) sb[640] = fexp(gtot + mcar - mnew);
    return mnew;
}
__device__ __forceinline__ void mlstm_unit(KArgs kp, int l, int u, LAS unsigned char* lds, bool dry = false) {
    const Args A = load_args(kp);
    unsigned char* ws = A.ws; OPQ(ws); OPQ(l);
    const int tid = opq_tid(), lane = tid & 63, w = tid >> 6, fr = lane & 15, fq = lane >> 4;
    const int pr_ = (u & 7) * 4 + (u >> 6), js = (u >> 3) & 7, b = pr_ >> 2, h = pr_ & 3;
    bf16* Z = (bf16*)(ws + WS_Z); const bf16* QKC = (const bf16*)(ws + WS_XB); const float* GT = (const float*)(ws + WS_GATES);
    LAS bf16* Ks = (LAS bf16*)(lds + ML_K); LAS bf16* Vs = (LAS bf16*)(lds + ML_V); LAS bf16* Vw = (LAS bf16*)(lds + ML_VW); LAS bf16* CsT = (LAS bf16*)(lds + ML_C);
    const float bi = A.b_igate[l * 4 + h], bfg = A.b_fgate[l * 4 + h];
    f32x4 st[2][3];
#pragma unroll
    for (int a = 0; a < 2; ++a)
#pragma unroll
        for (int c = 0; c < 3; ++c) st[a][c] = (f32x4){0.f, 0.f, 0.f, 0.f};
    float mcar = -INFINITY;
    const size_t tb = (size_t)b * SEQ;
    const int vs = tid >> 2, vch = tid & 3;
    u32x4 kreg[8]; u32x4 vraw; bf16x8 qf[8];
    LAS f32x2_t* gl = (LAS f32x2_t*)(lds + ML_G);
    {   float ga[8], gb[8];
#pragma unroll
        for (int k = 0; k < 8; ++k) { const float* gp = GT + (tb + tid + 512 * k) * 8; ga[k] = gp[h]; gb[k] = gp[4 + h]; }
#pragma unroll
        for (int k = 0; k < 8; ++k) gl[tid + 512 * k] = (f32x2_t){ga[k] + bi, gb[k] + bfg};
    }
#pragma unroll
    for (int k = 0; k < 8; ++k) { const int idx = tid + 512 * k, sr = idx >> 5, ch = idx & 31; kreg[k] = *(const u32x4*)(QKC + (tb + sr) * 2048 + 1024 + h * 256 + 8 * ch); }
    vraw = *(const u32x4*)(Z + (tb + vs) * NZ + Z_MV + h * 256 + 32 * js + 8 * vch);
    { const bf16* qp = QKC + (tb + 16 * w + fr) * 2048 + h * 256 + 8 * fq;
#pragma unroll
      for (int ks = 0; ks < 8; ++ks) qf[ks] = __builtin_bit_cast(bf16x8, *(const u32x4*)(qp + 32 * ks)); }
    __syncthreads();
    if (w == 0) { const f32x2_t g0 = gl[2 * lane], g1 = gl[2 * lane + 1]; mcar = mlstm_scalars((LAS float*)(lds + ML_S), g0.x, g1.x, g0.y, g1.y, mcar, lane); }
    __syncthreads();
#pragma unroll 1
    for (int c = 0; c < 32; ++c) {
        const size_t t0 = tb + (size_t)c * 128, t1 = t0 + 128;
        const bool more = c < 31;
        LAS float* sb = (LAS float*)(lds + ML_S + (c & 1) * ML_SBUF); LAS float* sbn = (LAS float*)(lds + ML_S + ((c + 1) & 1) * ML_SBUF);
#pragma unroll
        for (int k = 0; k < 8; ++k) { const int idx = tid + 512 * k, sr = idx >> 5, ch = idx & 31; *(LAS u32x4*)(Ks + sr * ML_KLD + 8 * ch) = kreg[k]; }
        *(LAS u32x4*)(Vs + vs * ML_VLD + 8 * vch) = vraw;
        {   const float wt = sb[512 + vs]; float f[8]; UNPACK8(vraw, f);
#pragma unroll
            for (int e = 0; e < 8; ++e) f[e] *= wt;
            *(LAS u32x4*)(Vw + vs * ML_VLD + 8 * vch) = PACK8(f); }
        if (tid < 256) { const int sr = tid >> 1, ch = 4 + (tid & 1);
            *(LAS u32x4*)(Vs + sr * ML_VLD + 8 * ch) = (u32x4){(ch == 4) ? 0x3f80u : 0u, 0u, 0u, 0u};
            *(LAS u32x4*)(Vw + sr * ML_VLD + 8 * ch) = (u32x4){(ch == 4) ? f2bf(sb[512 + sr]) : 0u, 0u, 0u, 0u}; }
        __syncthreads();
        if (more) {
#pragma unroll
            for (int k = 0; k < 8; ++k) { const int idx = tid + 512 * k, sr = idx >> 5, ch = idx & 31; kreg[k] = *(const u32x4*)(QKC + (t1 + sr) * 2048 + 1024 + h * 256 + 8 * ch); }
            vraw = *(const u32x4*)(Z + (t1 + vs) * NZ + Z_MV + h * 256 + 32 * js + 8 * vch);
        }
        const int tq = 16 * w + fr;
        const float btq = sb[tq], mtq = sb[256 + tq], itr = sb[384 + tq];
        f32x4 num[3], qc[3];
#pragma unroll
        for (int nt = 0; nt < 3; ++nt) { num[nt] = (f32x4){0.f, 0.f, 0.f, 0.f}; qc[nt] = (f32x4){0.f, 0.f, 0.f, 0.f}; }
#pragma unroll 1
        for (int k2 = 0; k2 <= (w >> 1); ++k2) {
            u32x4 pp;
            {   f32x4 a0 = {0.f, 0.f, 0.f, 0.f};
#pragma unroll
                for (int ks = 0; ks < 8; ++ks) a0 = mfma16(frag_kc(Ks, ML_KLD, 32 * k2, 32 * ks, lane), qf[ks], a0);
                const f32x4 us = *(const LAS f32x4*)(sb + 128 + 32 * k2 + 4 * fq);
                const bool diag = (2 * k2 == w);
                float p[4];
#pragma unroll
                for (int j = 0; j < 4; ++j) p[j] = (!diag || 4 * fq + j <= fr) ? a0[j] * fexp(btq + us[j] - mtq) : 0.f;
                pp.x = pk2(p[0], p[1]); pp.y = pk2(p[2], p[3]); }
            if (2 * k2 + 1 <= w) {
                f32x4 a1 = {0.f, 0.f, 0.f, 0.f};
#pragma unroll
                for (int ks = 0; ks < 8; ++ks) a1 = mfma16(frag_kc(Ks, ML_KLD, 32 * k2 + 16, 32 * ks, lane), qf[ks], a1);
                const f32x4 us = *(const LAS f32x4*)(sb + 128 + 32 * k2 + 16 + 4 * fq);
                const bool diag = (2 * k2 + 1 == w);
                float p[4];
#pragma unroll
                for (int j = 0; j < 4; ++j) p[j] = (!diag || 4 * fq + j <= fr) ? a1[j] * fexp(btq + us[j] - mtq) : 0.f;
                pp.z = pk2(p[0], p[1]); pp.w = pk2(p[2], p[3]);
            } else { pp.z = 0u; pp.w = 0u; }
            const bf16x8 pf = __builtin_bit_cast(bf16x8, pp);
#pragma unroll
            for (int nt = 0; nt < 3; ++nt) num[nt] = mfma16(frag_ks_pair(Vs, ML_VLD, 32 * k2, 16 * nt, lane), pf, num[nt]);
        }
        if (more && w == 0) { const f32x2_t g0 = gl[(c + 1) * 128 + 2 * lane], g1 = gl[(c + 1) * 128 + 2 * lane + 1]; mcar = mlstm_scalars(sbn, g0.x, g1.x, g0.y, g1.y, mcar, lane); }
        if (c > 0) {
#pragma unroll
            for (int ks = 0; ks < 8; ++ks)
#pragma unroll
                for (int nt = 0; nt < 3; ++nt) qc[nt] = mfma16(frag_kc(CsT, ML_CLD, 16 * nt, 32 * ks, lane), qf[ks], qc[nt]);
        }
        if (more) { const bf16* qp = QKC + (t1 + 16 * w + fr) * 2048 + h * 256 + 8 * fq;
#pragma unroll
            for (int ks = 0; ks < 8; ++ks) qf[ks] = __builtin_bit_cast(bf16x8, *(const u32x4*)(qp + 32 * ks)); }
        {
            const float dd = num[2][0] + itr * qc[2][0]; const float den = __shfl(dd, fr);
            const float inv = frcp(fmaxf(fabsf(den), fexp(-mtq)));
            bf16* hp = dry ? (bf16*)ws + tid * 64 : Z + (t0 + tq) * NZ + Z_MV + h * 256 + 32 * js;
#pragma unroll
            for (int nt = 0; nt < 2; ++nt) *(u32x2*)(hp + 16 * nt + 4 * fq) = (u32x2){pk2((num[nt][0] + itr * qc[nt][0]) * inv, (num[nt][1] + itr * qc[nt][1]) * inv), pk2((num[nt][2] + itr * qc[nt][2]) * inv, (num[nt][3] + itr * qc[nt][3]) * inv)};
        }
        {
            const float dec = sb[640];
#pragma unroll
            for (int a = 0; a < 2; ++a)
#pragma unroll
                for (int nt = 0; nt < 3; ++nt) st[a][nt] = st[a][nt] * dec;
#pragma unroll
            for (int ks = 0; ks < 4; ++ks) {
                bf16x8 bfr[3];
#pragma unroll
                for (int nt = 0; nt < 3; ++nt) bfr[nt] = frag_ks(Vw, ML_VLD, 32 * ks, 16 * nt, lane);
#pragma unroll
                for (int a = 0; a < 2; ++a) { const bf16x8 af = frag_ks(Ks, ML_KLD, 32 * ks, 32 * w + 16 * a, lane);
#pragma unroll
                    for (int nt = 0; nt < 3; ++nt) st[a][nt] = mfma16(af, bfr[nt], st[a][nt]); }
            }
        }
        __syncthreads();
#pragma unroll
        for (int a = 0; a < 2; ++a)
#pragma unroll
            for (int nt = 0; nt < 3; ++nt)
                *(LAS u32x2*)(CsT + (16 * nt + fr) * ML_CLD + 32 * w + 16 * a + 4 * fq) = (u32x2){pk2(st[a][nt][0], st[a][nt][1]), pk2(st[a][nt][2], st[a][nt][3])};
    }
    __syncthreads();
}

__device__ __forceinline__ void finish_phase(KArgs kp, int l, int G) {
    const Args A = load_args(kp);
    unsigned char* ws = A.ws; OPQ(ws); OPQ(l);
    const int tid = opq_tid(), lane = tid & 63, wave = tid >> 6, gw = blockIdx.x * 8 + wave, NGW = G * 8;
    const bf16* Z = (const bf16*)(ws + WS_Z); const float* LSE = (const float*)(ws + WS_LSE); bf16* MIX = (bf16*)(ws + WS_XB);
    float hg[16];
#pragma unroll
    for (int e = 0; e < 16; ++e) hg[e] = A.head_norm_g[l * 1024 + 16 * lane + e];
    for (int m = gw; m < M; m += NGW) {
        const bf16* zr = Z + (size_t)m * NZ; bf16* mr = MIX + (size_t)m * 2048;
        {
            const int hh = lane >> 3; const float* lp = LSE + (size_t)m * 24 + hh;
            const float l0 = lp[0], l1 = lp[8], l2 = lp[16], mx = fmaxf(l0, fmaxf(l1, l2));
            float e0 = fexp(l0 - mx), e1 = fexp(l1 - mx), e2 = fexp(l2 - mx); const float inv = frcp(e0 + e1 + e2); e0 *= inv; e1 *= inv; e2 *= inv;
            const u32x4 r0 = *(const u32x4*)(zr + Z_AQ + 8 * lane), r1 = *(const u32x4*)(zr + Z_AQ + 512 + 8 * lane), r2 = *(const u32x4*)(zr + Z_AQ + 1024 + 8 * lane), rg = *(const u32x4*)(zr + Z_AG + 8 * lane);
            float o0[8], o1[8], o2[8], gg[8], y[8]; UNPACK8(r0, o0); UNPACK8(r1, o1); UNPACK8(r2, o2); UNPACK8(rg, gg);
#pragma unroll
            for (int e = 0; e < 8; ++e) y[e] = (e0 * o0[e] + e1 * o1[e] + e2 * o2[e]) * silu_f(gg[e]);
            *(u32x4*)(mr + 8 * lane) = PACK8(y);
        }
        *(u32x4*)(mr + 512 + 8 * lane) = *(const u32x4*)(zr + Z_SU + 8 * lane);
        {
            float x[16], gm[16];
#pragma unroll
            for (int c2 = 0; c2 < 2; ++c2) { const u32x4 hv = *(const u32x4*)(zr + Z_MV + 16 * lane + 8 * c2), ov = *(const u32x4*)(zr + Z_MO + 16 * lane + 8 * c2), gv = *(const u32x4*)(zr + Z_MG + 16 * lane + 8 * c2);
                float hf[8], of[8], gf[8]; UNPACK8(hv, hf); UNPACK8(ov, of); UNPACK8(gv, gf);
#pragma unroll
                for (int e = 0; e < 8; ++e) { x[8 * c2 + e] = hf[e] * sigmoid_f(of[e]); gm[8 * c2 + e] = gf[e]; } }
            float s = 0.f;
#pragma unroll
            for (int e = 0; e < 16; ++e) s += x[e];
            const float mean = sum16(s) * (1.f / 256.f); float q = 0.f;
#pragma unroll
            for (int e = 0; e < 16; ++e) { x[e] -= mean; q += x[e] * x[e]; }
            const float rstd = frsq(sum16(q) * (1.f / 256.f) + LN_EPS);
            float y0[8], y1[8];
#pragma unroll
            for (int e = 0; e < 8; ++e) { y0[e] = x[e] * rstd * hg[e] * silu_f(gm[e]); y1[e] = x[8 + e] * rstd * hg[8 + e] * silu_f(gm[8 + e]); }
            *(u32x4*)(mr + 1024 + 16 * lane) = PACK8(y0); *(u32x4*)(mr + 1024 + 16 * lane + 8) = PACK8(y1);
        }
    }
}

__device__ __forceinline__ void ln_phase(KArgs kp, int l, int G, LAS unsigned char* lds) {
    const Args A = load_args(kp);
    unsigned char* ws = A.ws; OPQ(ws); OPQ(l);
    const int tid = opq_tid(), lane = tid & 63, wave = tid >> 6, gw = blockIdx.x * 8 + wave, NGW = G * 8;
    const bool more = (l + 1 < DEPTH);
    LAS f32x4* wg = (LAS f32x4*)lds;
    if (more) { load_gate_w(A.w_in + (size_t)(l + 1) * D * DIN, wg); }
    __syncthreads();
    bf16* XB = (bf16*)(ws + WS_XB); float* GT = (float*)(ws + WS_GATES);
    f32x4 gv[8], bv[8];
#pragma unroll
    for (int i = 0; i < 8; ++i) { gv[i] = *((const f32x4*)(A.ln_g + (size_t)l * D) + lane + 64 * i); bv[i] = *((const f32x4*)(A.ln_b + (size_t)l * D) + lane + 64 * i); }
    for (int m = gw; m < M; m += NGW) {
        f32x4* xr = (f32x4*)(A.out + (size_t)m * D) + lane;
        f32x4 v[8]; float s = 0.f;
#pragma unroll
        for (int i = 0; i < 8; ++i) { v[i] = xr[64 * i]; s += (v[i][0] + v[i][1]) + (v[i][2] + v[i][3]); }
        const float mean = wave_sum(s) * (1.f / D); float q = 0.f;
#pragma unroll
        for (int i = 0; i < 8; ++i) { v[i] = v[i] - mean; q += (v[i][0] * v[i][0] + v[i][1] * v[i][1]) + (v[i][2] * v[i][2] + v[i][3] * v[i][3]); }
        const float rstd = frsq(wave_sum(q) * (1.f / D) + LN_EPS);
#pragma unroll
        for (int i = 0; i < 8; ++i) { v[i] = v[i] * rstd * gv[i] + bv[i]; xr[64 * i] = v[i]; }
        if (more) {
            u32x2* o = (u32x2*)(XB + (size_t)m * D) + lane;
#pragma unroll
            for (int i = 0; i < 8; ++i) o[64 * i] = (u32x2){pk2(v[i][0], v[i][1]), pk2(v[i][2], v[i][3])};
            gate_dots(v, wg, GT + (size_t)m * 8, lane);
        }
    }
    __syncthreads();
}

constexpr size_t WS_BAR = 512 * 1024;
constexpr int LDS_MISC = LDS_BYTES - 64;
#define XB_TMO      128
#define XB_XCNT(j)  (256  + 64 * (j))
#define XB_XSUB(j)  (1280 + 64 * (j))
#define XB_XGEN(j)  (2304 + 64 * (j))
#define XB_TOP      3328
#define XB_TOPGEN   3392
#define XCD_BAR_WORDS 3456
#define XB_SPIN_CAP (1u << 18)

__device__ __forceinline__ unsigned xb_ld(unsigned* p)              { return __hip_atomic_load(p, __ATOMIC_RELAXED, __HIP_MEMORY_SCOPE_AGENT); }
__device__ __forceinline__ unsigned xb_add(unsigned* p, unsigned v) { return __hip_atomic_fetch_add(p, v, __ATOMIC_RELAXED, __HIP_MEMORY_SCOPE_AGENT); }
__device__ __forceinline__ unsigned xb_xcc_id() { return (unsigned)__builtin_amdgcn_s_getreg((3 << 11) | 20) & 0xFu; }
#define XB_SPIN(cond, bar) do { unsigned _sp = 0; while (cond) { __builtin_amdgcn_s_sleep(1); \
    if ((++_sp & 255u) == 0u) { if (xb_ld(&(bar)[XB_TMO])) break; if (_sp > XB_SPIN_CAP) { atomicAdd(&(bar)[XB_TMO], 1u); break; } } } } while (0)

struct XcdBarrier {
    unsigned* bar; unsigned x;
    volatile LAS unsigned* st;
};

__device__ __forceinline__ XcdBarrier xcd_barrier_post(unsigned* bar, volatile LAS unsigned* st) {
    XcdBarrier b; b.bar = bar; b.x = xb_xcc_id(); b.st = st;
    if (threadIdx.x == 0) (void)xb_add(&bar[XB_XCNT(b.x)], 1u);
    return b;
}
__device__ __forceinline__ void xcd_barrier_complete(unsigned* bar, unsigned x, unsigned& nloc, unsigned& nx) {
    const unsigned G = gridDim.x * gridDim.y * gridDim.z;
    unsigned sum, cnt, mine, sp = 0u;
    for (;;) {
        sum = 0u; cnt = 0u; mine = 0u;
#pragma unroll
        for (unsigned j = 0; j < 16; ++j) { const unsigned c = xb_ld(&bar[XB_XCNT(j)]); sum += c; cnt += (c > 0u) ? 1u : 0u; mine = (j == x) ? c : mine; }
        if (sum == G) break;
        __builtin_amdgcn_s_sleep(1);
        if ((++sp & 255u) == 0u) { if (xb_ld(&bar[XB_TMO])) break; if (sp > XB_SPIN_CAP) { atomicAdd(&bar[XB_TMO], 1u); break; } }
    }
    nloc = mine > 0u ? mine : 1u; nx = cnt > 0u ? cnt : 1u;
}

__device__ __forceinline__ void xcd_barrier(const XcdBarrier& b) {
    asm volatile("s_waitcnt vmcnt(0)" ::: "memory");
    __syncthreads();
    if (threadIdx.x == 0) {
        unsigned* bar = b.bar;
        __builtin_amdgcn_s_waitcnt(0);
        unsigned nloc = b.st[0], nx = b.st[1];
        if (nloc == 0u) { xcd_barrier_complete(bar, b.x, nloc, nx); b.st[0] = nloc; b.st[1] = nx; }
        const unsigned old = xb_add(&bar[XB_XSUB(b.x)], 1u);
        const unsigned gen = old / nloc;
        if (old + 1u == (gen + 1u) * nloc) {
            __builtin_amdgcn_fence(__ATOMIC_RELEASE, "agent");
            asm volatile("s_waitcnt vmcnt(0)" ::: "memory");
            const unsigned og = xb_add(&bar[XB_TOP], 1u);
            const unsigned tg = og / nx;
            if (og + 1u == (tg + 1u) * nx) xb_add(&bar[XB_TOPGEN], 1u);
            else XB_SPIN(xb_ld(&bar[XB_TOPGEN]) == tg, bar);
            __builtin_amdgcn_fence(__ATOMIC_ACQUIRE, "agent");
            xb_add(&bar[XB_XGEN(b.x)], 1u);
            asm volatile("s_waitcnt vmcnt(0)" ::: "memory");
        } else {
            XB_SPIN(xb_ld(&bar[XB_XGEN(b.x)]) == gen, bar);
            __builtin_amdgcn_fence(__ATOMIC_ACQUIRE, "agent");
            asm volatile("s_waitcnt vmcnt(0)" ::: "memory");
        }
    }
    __syncthreads();
}


__global__ void __launch_bounds__(512, 2) fwd_megakernel(Args A_unused) {
    const KArgs kp = (KArgs)__builtin_amdgcn_kernarg_segment_ptr();
    extern __shared__ __attribute__((aligned(16))) unsigned char lds_raw[];
    LAS unsigned char* lds = (LAS unsigned char*)lds_raw;
    cg::grid_group grid = cg::this_grid();
    const int G = gridDim.x, bid = blockIdx.x;
    if (threadIdx.x < 16) ((LAS unsigned*)(lds + LDS_MISC))[threadIdx.x] = 0u;
    __syncthreads();
    XcdBarrier xbar;
    { const Args A0 = load_args(kp); xbar = xcd_barrier_post((unsigned*)(A0.ws + WS_BAR), (volatile LAS unsigned*)(lds + LDS_MISC)); }
#define GRID_SYNC() xcd_barrier(xbar)
#ifndef NO_P0
    p0_prologue(kp, lds, G);
#endif
#ifdef PROBE_P0
    GRID_SYNC(); p0_prologue(kp, lds, G);
#endif
    grid.sync();
#pragma unroll
    for (int l = 0; l < DEPTH; ++l) {
        {
            const Args A = load_args(kp);
            pg8::Gemm g{(const pg8::bf16_t*)(A.ws + WS_XB), (const pg8::bf16_t*)(A.ws + WS_WIN + l * WIN_BYTES), M, NZ, D};
            pg8::StaticOrder S; S.init(M, NZ, G, bid);
            pg8::EpiBf16<0> E{(pg8::bf16_t*)(A.ws + WS_Z), NZ, nullptr, 0, 0, 1.f};
#ifndef NO_G1
            pg8::gemm_phase<pg8::EpiBf16<0>, pg8::StaticOrder, true, true>(lds, g, S, E);
#endif
#ifdef PROBE_G1
            GRID_SYNC(); pg8::gemm_phase<pg8::EpiBf16<0>, pg8::StaticOrder, true, true>(lds, g, S, E);
#endif
        }
        GRID_SYNC();
#ifdef PROBE_P2
        {   attn_phase(kp, lds, G, true);
            constexpr int N_SGU = 256, N_CONV = 1024;
            for (int it = bid; it < N_SGU + N_CONV; it += G) {
                if (it < N_SGU) sgu_unit(kp, l, it, lds, true);
                if (it >= N_SGU) conv_unit(kp, l, it - N_SGU);
            }
        }
        GRID_SYNC();
#endif
#ifdef PROBE_SGU
        for (int it = bid; it < 256; it += G) sgu_unit(kp, l, it, lds, true);
        GRID_SYNC();
#endif
#ifdef PROBE_CONV
        for (int it = bid; it < 1024; it += G) conv_unit(kp, l, it);
        GRID_SYNC();
#endif
#ifdef PROBE_ATT
        attn_phase(kp, lds, G, true);
        GRID_SYNC();
#endif
        {
#ifndef NO_ATT
            attn_phase(kp, lds, G);
#endif
            constexpr int N_SGU = 256, N_CONV = 1024;
            for (int it = bid; it < N_SGU + N_CONV; it += G) {
#ifndef NO_SGU
                if (it < N_SGU) sgu_unit(kp, l, it, lds);
#endif
#ifndef NO_CONV
                if (it >= N_SGU) conv_unit(kp, l, it - N_SGU);
#endif
            }
        }
        GRID_SYNC();
#ifdef PROBE_ML
        for (int it = bid; it < 256; it += G) mlstm_unit(kp, l, it, lds, true);
        GRID_SYNC();
#endif
#ifndef NO_ML
        for (int it = bid; it < 256; it += G) mlstm_unit(kp, l, it, lds);
#endif
        GRID_SYNC();
#ifndef NO_FIN
        finish_phase(kp, l, G);
#endif
#ifdef PROBE_FIN
        GRID_SYNC(); finish_phase(kp, l, G);
#endif
        GRID_SYNC();
        {
            const Args A = load_args(kp);
            pg8::Gemm g{(const pg8::bf16_t*)(A.ws + WS_XB), (const pg8::bf16_t*)(A.ws + WS_WOUT + l * WOUT_BYTES), M, D, D};
            pg8::StaticOrder S; S.init(M, D, G, bid);
            pg8::EpiResF32 E{l == 0 ? A.x : (const float*)A.out, A.out, D, 1.41421356237f};
#ifndef NO_G2
            pg8::gemm_phase<pg8::EpiResF32, pg8::StaticOrder, true, true>(lds, g, S, E);
#endif
#ifdef PROBE_G2
            if (l == 0) { GRID_SYNC(); pg8::gemm_phase<pg8::EpiResF32, pg8::StaticOrder, true, true>(lds, g, S, E); }
#endif
        }
        GRID_SYNC();
#ifdef PROBE_SYNC
        for (int i = 0; i < 10; ++i) GRID_SYNC();
#endif
#ifndef NO_LN
        ln_phase(kp, l, G, lds);
#endif
        if (l + 1 < DEPTH) GRID_SYNC();
    }
}

extern "C" void kernel_launch(void* const* d_in, const int* in_sizes, int n_in, void* d_out, int out_size, void* d_ws, size_t ws_size, hipStream_t stream) {
    static int grid = 0;
    if (grid == 0) {
        if (n_in != 15 || out_size != M * D || ws_size < WS_END) { fprintf(stderr, "kernel_launch: unexpected shapes (n_in %d out %d ws %zu need %zu)\n", n_in, out_size, ws_size, (size_t)WS_END); grid = -1; return; }
        int dev = 0, cus = 0, per_cu = 0;
        (void)hipGetDevice(&dev);
        (void)hipDeviceGetAttribute(&cus, hipDeviceAttributeMultiprocessorCount, dev);
        (void)hipFuncSetAttribute((const void*)fwd_megakernel, hipFuncAttributeMaxDynamicSharedMemorySize, LDS_BYTES);
        (void)hipOccupancyMaxActiveBlocksPerMultiprocessor(&per_cu, (const void*)fwd_megakernel, 512, LDS_BYTES);
        if (per_cu < 1) per_cu = 1;
        grid = cus * per_cu;
    }
    if (grid < 0) return;
    Args a{};
    a.x = (const float*)d_in[0]; a.pos = (const int*)d_in[1]; a.w_in = (const float*)d_in[2]; a.sgu_ln_g = (const float*)d_in[3]; a.sgu_ln_b = (const float*)d_in[4];
    a.w_spatial = (const float*)d_in[5]; a.b_spatial = (const float*)d_in[6]; a.conv_w = (const float*)d_in[7]; a.conv_b = (const float*)d_in[8];
    a.b_igate = (const float*)d_in[9]; a.b_fgate = (const float*)d_in[10]; a.head_norm_g = (const float*)d_in[11]; a.w_out = (const float*)d_in[12];
    a.ln_g = (const float*)d_in[13]; a.ln_b = (const float*)d_in[14]; a.out = (float*)d_out; a.ws = (unsigned char*)d_ws;
    (void)hipMemsetAsync((unsigned char*)d_ws + WS_BAR, 0, XCD_BAR_WORDS * 4, stream);
    void* args[] = {&a};
    hipError_t e = hipLaunchCooperativeKernel((void*)fwd_megakernel, dim3(grid), dim3(512), args, LDS_BYTES, stream);
    if (e != hipSuccess) fprintf(stderr, "cooperative launch failed: %s (grid %d)\n", hipGetErrorString(e), grid);
}
```

```cpp
#include <hip/hip_runtime.h>
#include <hip/hip_cooperative_groups.h>
#include <cstdio>
#include <cstdint>
namespace cg = cooperative_groups;
namespace pg8 {
#define PG8_LAS __attribute__((address_space(3)))
typedef unsigned short bf16_t;
typedef short bf16x8 __attribute__((ext_vector_type(8)));
typedef float f32x4 __attribute__((ext_vector_type(4)));
typedef unsigned u32x4 __attribute__((ext_vector_type(4)));
constexpr int BM = 256, BK = 64, HALF = 128, HTB = HALF * BK * 2  , STAGE_BYTES = 8 * HTB, NXCD = 8, WGM = 8;

__host__ __device__ __forceinline__ int lds_byte(int r, int c) { const int st = (r >> 4) * 2 + (c >> 5), rr = r & 15, cc = c & 31, ob = rr * 64 + cc * 2; return st * 1024 + (ob ^ (((ob >> 9) & 1) << 5)); }
__host__ __device__ __forceinline__ void stage_rc(int b, int& R, int& C) { const int st = b / 1024, sb = b % 1024, swz = sb ^ (((sb >> 9) & 1) << 5); R = (st >> 1) * 16 + swz / 64; C = (st & 1) * 32 + (swz % 64) / 2; }
__host__ __device__ __forceinline__ int perm32(int rho) { const int n = rho >> 4, i = rho & 15; return 8 * (i >> 2) + 4 * n + (i & 3); }

struct Unit { int pm, pn; };
struct Gemm { const bf16_t* A; const bf16_t* Bt; int M, N, K; };

struct StaticOrder {
    int nM, nN, nwg, G, c;
    __host__ __device__ void init(int M, int N, int G_, int c_) { nM = M / BM; nN = N / BM; nwg = nM * nN; G = G_; c = c_; }
    __host__ __device__ bool next(int i, Unit& u) const {
        const long L = (long)i * G + c; if (L >= nwg) return false;
        int wgid = (int)L; { const int q = nwg / NXCD, r = nwg % NXCD, xcd = wgid % NXCD, off = wgid / NXCD; wgid = (xcd < r ? xcd * (q + 1) : r * (q + 1) + (xcd - r) * q) + off; }
        const int nig = WGM * nN, gid = wgid / nig, fm = gid * WGM, gsz = (nM - fm) < WGM ? (nM - fm) : WGM;
        u.pm = fm + ((wgid % nig) % gsz); u.pn = (wgid % nig) / gsz; return true;
    }
    __device__ __forceinline__ void a_ready(const Unit&) const {}
    __device__ __forceinline__ void done(const Unit&) const {}
};

__device__ __forceinline__ unsigned cvt_pk_bf16(float lo, float hi) { unsigned r; asm volatile("v_cvt_pk_bf16_f32 %0, %1, %2" : "=v"(r) : "v"(lo), "v"(hi)); return r; }
typedef float f32x2 __attribute__((ext_vector_type(2)));
__device__ __forceinline__ f32x2 gelu_pk(f32x2 v) {
    const f32x2 av = __builtin_elementwise_abs(v), d = av * 0.2316418882f + 1.0f;
    f32x2 t; t.x = __builtin_amdgcn_rcpf(d.x); t.y = __builtin_amdgcn_rcpf(d.y);
    f32x2 q = t * 0.5307027145f + (-0.7265760135f); q = q * t + 0.7107068705f; q = q * t + (-0.142248368f); q = q * t + 0.127414796f; q = q * t;
    const f32x2 s = (v * v) * (-0.72134752044f);
    f32x2 e; e.x = __builtin_amdgcn_exp2f(s.x); e.y = __builtin_amdgcn_exp2f(s.y);
    const f32x2 m = v * (q * e), r = v - m;
    f32x2 o; o.x = v.x < 0.f ? m.x : r.x; o.y = v.y < 0.f ? m.y : r.y; return o;
}

template <int ACT  > struct EpiBf16 {
    static constexpr bool PERM = true, AFTER_DRAIN = false; static_assert(ACT == 0 || ACT == 1, "EpiBf16: ACT is 0 (none) or 1 (gelu_pk)");
    bf16_t* O; int ldc; const float* bias; int split_cols; size_t split_stride; float scale0;
    __device__ __forceinline__ void operator()(const f32x4 (&acc)[2][2][4][2], const Unit& u, int wr, int wc, int fr, int fq) const {
        const int row0 = u.pm * BM + wr * 64 + fr; int colt = u.pn * BM; bf16_t* base = O;
        float sc = 1.f; if (split_cols) { const int t = colt / split_cols; base += (size_t)t * split_stride; colt -= t * split_cols; if (t == 0) sc = scale0; }
        const int col0 = colt + wc * 32 + 8 * fq, bcol0 = u.pn * BM + wc * 32 + 8 * fq;
        f32x4 bv[2][2];
#pragma unroll
        for (int bj = 0; bj < 2; ++bj)
#pragma unroll
            for (int n = 0; n < 2; ++n) bv[bj][n] = bias ? *(const f32x4*)(bias + bcol0 + bj * HALF + 4 * n) : (f32x4){0.f, 0.f, 0.f, 0.f};
#pragma unroll
        for (int ai = 0; ai < 2; ++ai)
#pragma unroll
            for (int m = 0; m < 4; ++m) { bf16_t* rowp = base + (size_t)(row0 + ai * HALF + m * 16) * ldc + col0;
#pragma unroll
                for (int bj = 0; bj < 2; ++bj) { f32x4 v0 = acc[ai][bj][m][0] + bv[bj][0], v1 = acc[ai][bj][m][1] + bv[bj][1];
                    if (ACT == 1) { f32x2 a = gelu_pk((f32x2){v0[0], v0[1]}), b = gelu_pk((f32x2){v0[2], v0[3]}), c = gelu_pk((f32x2){v1[0], v1[1]}), d = gelu_pk((f32x2){v1[2], v1[3]});
                        v0 = (f32x4){a.x, a.y, b.x, b.y}; v1 = (f32x4){c.x, c.y, d.x, d.y}; }
                    v0 = v0 * sc; v1 = v1 * sc; u32x4 w; w.x = cvt_pk_bf16(v0[0], v0[1]); w.y = cvt_pk_bf16(v0[2], v0[3]); w.z = cvt_pk_bf16(v1[0], v1[1]); w.w = cvt_pk_bf16(v1[2], v1[3]);
                    *(u32x4*)(rowp + bj * HALF) = w; } }
    }
};
struct EpiResF32 {
    static constexpr bool PERM = true, AFTER_DRAIN = false;
    const float* R; float* O; int ldc; float alpha;
    __device__ __forceinline__ void operator()(const f32x4 (&acc)[2][2][4][2], const Unit& u, int wr, int wc, int fr, int fq) const {
        const int row0 = u.pm * BM + wr * 64 + fr, col0 = u.pn * BM + wc * 32 + 8 * fq;
#pragma unroll
        for (int ai = 0; ai < 2; ++ai)
#pragma unroll
            for (int m = 0; m < 4; ++m) {
                const size_t ro = (size_t)(row0 + ai * HALF + m * 16) * ldc + col0;
#pragma unroll
                for (int bj = 0; bj < 2; ++bj) {
                    const f32x4 r0 = *(const f32x4*)(R + ro + bj * HALF), r1 = *(const f32x4*)(R + ro + bj * HALF + 4);
                    *(f32x4*)(O + ro + bj * HALF) = r0 * alpha + acc[ai][bj][m][0];
                    *(f32x4*)(O + ro + bj * HALF + 4) = r1 * alpha + acc[ai][bj][m][1];
                }
            }
    }
};
template <class Epi, class Sched, bool ALIGN_EPI = false, bool SP2 = false>
__device__ __forceinline__ void gemm_phase(PG8_LAS unsigned char* lds, const Gemm g, const Sched& S, const Epi& E) {
    int tid_l = threadIdx.x; asm volatile("" : "+v"(tid_l));
    const int tid = tid_l, wid = __builtin_amdgcn_readfirstlane(tid >> 6), lane = tid & 63, wr = wid >> 2, wc = wid & 3, fr = lane & 15, fq = lane >> 4;
    const int K = g.K, nt = K / BK;
    unsigned voffA[2], voffB[2];
#pragma unroll
    for (int i = 0; i < 2; ++i) { int R, C; stage_rc(tid * 16 + i * 8192, R, C); const int Rb = Epi::PERM ? ((R & ~31) + perm32(R & 31)) : R;
        voffA[i] = (unsigned)(R * K + C) * 2u; voffB[i] = (unsigned)(Rb * K + C) * 2u; }
    const size_t kstep = (size_t)(BK * 2);
    const size_t hstep = (size_t)HALF * K * 2;
    const size_t tstep = 2 * hstep;
    const unsigned ldsw = (unsigned)wid * 1024u;
    const int aoff = lds_byte(wr * 64 + fr, fq * 8), boff = lds_byte(wc * 32 + fr, fq * 8);
#define PG8_SA(b, h) (((b) * 2 + (h)) * HTB)
#define PG8_SB(b, h) ((4 + (b) * 2 + (h)) * HTB)
#define PG8_STAGE(bufoff, gbase, voff) do { _Pragma("unroll") for (int _i = 0; _i < 2; ++_i) \
        __builtin_amdgcn_global_load_lds((const unsigned*)((const char*)(gbase) + (voff)[_i]), (PG8_LAS unsigned*)(lds + (bufoff) + ldsw + _i * 8192), 16, 0, 0); } while (0)
#define PG8_LDA(dst, b, h) do { _Pragma("unroll") for (int m = 0; m < 4; ++m) _Pragma("unroll") for (int k = 0; k < 2; ++k) dst[m][k] = *(const PG8_LAS bf16x8*)(lds + PG8_SA(b, h) + aoff + m * 2048 + k * 1024); } while (0)
#define PG8_LDB(dst, b, h) do { _Pragma("unroll") for (int n = 0; n < 2; ++n) _Pragma("unroll") for (int k = 0; k < 2; ++k) dst[n][k] = *(const PG8_LAS bf16x8*)(lds + PG8_SB(b, h) + boff + n * 2048 + k * 1024); } while (0)
#define PG8_MMA(ai, bj, At, Bt) do { __builtin_amdgcn_s_setprio(1); _Pragma("unroll") for (int m = 0; m < 4; ++m) _Pragma("unroll") for (int n = 0; n < 2; ++n) _Pragma("unroll") for (int k = 0; k < 2; ++k) \
        acc[ai][bj][m][n] = __builtin_amdgcn_mfma_f32_16x16x32_bf16(Bt[n][k], At[m][k], acc[ai][bj][m][n], 0, 0, 0); __builtin_amdgcn_s_setprio(0); } while (0)
#define PG8_WAIT_V(n) asm volatile("s_waitcnt vmcnt(" #n ")" ::: "memory")
#define PG8_WAIT_L(n) asm volatile("s_waitcnt lgkmcnt(" #n ")" ::: "memory")
#define PG8_BAR __builtin_amdgcn_s_barrier()
#define PG8_SCHED __builtin_amdgcn_sched_barrier(0)
    Unit cur, nxt; int ui = 0;
    if (!S.next(0, cur)) return;
    f32x4 acc[2][2][4][2];
#pragma unroll
    for (int a = 0; a < 2; ++a)
#pragma unroll
        for (int b = 0; b < 2; ++b)
#pragma unroll
            for (int m = 0; m < 4; ++m)
#pragma unroll
                for (int n = 0; n < 2; ++n) acc[a][b][m][n] = (f32x4){0.f, 0.f, 0.f, 0.f};
    bf16x8 At[4][2], B0[2][2], B1[2][2];
    const char* cA = (const char*)g.A + (size_t)cur.pm * tstep; const char* cB = (const char*)g.Bt + (size_t)cur.pn * tstep;
    S.a_ready(cur);
    if constexpr (SP2) {
        PG8_STAGE(PG8_SB(0, 0), cB, voffB); PG8_STAGE(PG8_SB(0, 1), cB + hstep, voffB); PG8_STAGE(PG8_SA(0, 0), cA, voffA); PG8_STAGE(PG8_SA(0, 1), cA + hstep, voffA);
        if (wr == 1) PG8_BAR;
        PG8_WAIT_V(2); PG8_BAR;
        PG8_STAGE(PG8_SB(1, 0), cB + kstep, voffB); PG8_STAGE(PG8_SA(1, 0), cA + kstep, voffA); PG8_STAGE(PG8_SB(1, 1), cB + hstep + kstep, voffB);
        PG8_WAIT_V(6); PG8_BAR;
    } else {
        PG8_STAGE(PG8_SB(0, 0), cB, voffB); PG8_STAGE(PG8_SA(0, 0), cA, voffA); PG8_STAGE(PG8_SB(0, 1), cB + hstep, voffB); PG8_STAGE(PG8_SA(0, 1), cA + hstep, voffA);
        if (wr == 1) PG8_BAR;
        PG8_WAIT_V(4); PG8_BAR;
        PG8_STAGE(PG8_SB(1, 0), cB + kstep, voffB); PG8_STAGE(PG8_SA(1, 0), cA + kstep, voffA); PG8_STAGE(PG8_SB(1, 1), cB + hstep + kstep, voffB);
        PG8_WAIT_V(6); PG8_BAR;
    }
    for (;;) {
        const bool has_next = S.next(ui + 1, nxt);
        const char* nA = has_next ? (const char*)g.A + (size_t)nxt.pm * tstep : cA; const char* nB = has_next ? (const char*)g.Bt + (size_t)nxt.pn * tstep : cB;
        for (int t = 0; t < nt; t += 2) {
            const bool last = (t == nt - 2);
            const char* a1 = cA + (size_t)(t + 1) * kstep;
            const char* a2 = last ? nA : cA + (size_t)(t + 2) * kstep; const char* b2 = last ? nB : cB + (size_t)(t + 2) * kstep;
            const char* a3 = a2 + kstep; const char* b3 = b2 + kstep;
            if (last && has_next) S.a_ready(nxt);
            if constexpr (SP2) {
            PG8_LDB(B0, 0, 0); PG8_LDB(B1, 0, 1); PG8_SCHED; PG8_LDA(At, 0, 0); PG8_STAGE(PG8_SA(1, 1), a1 + hstep, voffA);
            PG8_WAIT_V(8); PG8_WAIT_L(0); PG8_BAR; PG8_MMA(0, 0, At, B0); PG8_MMA(0, 1, At, B1); PG8_BAR; PG8_SCHED;
            PG8_LDA(At, 0, 1); PG8_STAGE(PG8_SB(0, 0), b2, voffB); PG8_STAGE(PG8_SB(0, 1), b2 + hstep, voffB); PG8_STAGE(PG8_SA(0, 0), a2, voffA);
            PG8_WAIT_V(8); PG8_WAIT_L(0); PG8_BAR; PG8_MMA(1, 0, At, B0); PG8_MMA(1, 1, At, B1); PG8_BAR; PG8_SCHED;
            PG8_LDB(B0, 1, 0); PG8_LDB(B1, 1, 1); PG8_SCHED; PG8_LDA(At, 1, 0); PG8_STAGE(PG8_SA(0, 1), a2 + hstep, voffA);
            PG8_WAIT_V(8); PG8_WAIT_L(0); PG8_BAR; PG8_MMA(0, 0, At, B0); PG8_MMA(0, 1, At, B1); PG8_BAR; PG8_SCHED;
            PG8_LDA(At, 1, 1); PG8_STAGE(PG8_SB(1, 0), b3, voffB); PG8_STAGE(PG8_SB(1, 1), b3 + hstep, voffB); PG8_STAGE(PG8_SA(1, 0), a3, voffA);
            PG8_WAIT_V(8); PG8_WAIT_L(0); PG8_BAR; PG8_MMA(1, 0, At, B0); PG8_MMA(1, 1, At, B1); PG8_BAR; PG8_SCHED;
            } else {
            PG8_LDB(B0, 0, 0); PG8_SCHED; PG8_LDA(At, 0, 0); PG8_STAGE(PG8_SA(1, 1), a1 + hstep, voffA);
            PG8_WAIT_L(8); PG8_BAR; PG8_WAIT_L(0); PG8_MMA(0, 0, At, B0); PG8_BAR; PG8_SCHED;
            PG8_LDB(B1, 0, 1); PG8_STAGE(PG8_SB(0, 0), b2, voffB);
            PG8_BAR; PG8_WAIT_L(0); PG8_MMA(0, 1, At, B1); PG8_BAR;
            PG8_LDA(At, 0, 1); PG8_STAGE(PG8_SA(0, 0), a2, voffA);
            PG8_BAR; PG8_WAIT_L(0); PG8_MMA(1, 0, At, B0); PG8_BAR; PG8_SCHED;
            PG8_STAGE(PG8_SB(0, 1), b2 + hstep, voffB);
            PG8_WAIT_V(6); PG8_BAR; PG8_MMA(1, 1, At, B1); PG8_BAR;
            PG8_LDB(B0, 1, 0); PG8_SCHED; PG8_LDA(At, 1, 0); PG8_STAGE(PG8_SA(0, 1), a2 + hstep, voffA);
            PG8_WAIT_L(8); PG8_BAR; PG8_WAIT_L(0); PG8_MMA(0, 0, At, B0); PG8_BAR; PG8_SCHED;
            PG8_LDB(B1, 1, 1); PG8_STAGE(PG8_SB(1, 0), b3, voffB);
            PG8_BAR; PG8_WAIT_L(0); PG8_MMA(0, 1, At, B1); PG8_BAR;
            PG8_LDA(At, 1, 1); PG8_STAGE(PG8_SA(1, 0), a3, voffA);
            PG8_BAR; PG8_WAIT_L(0); PG8_MMA(1, 0, At, B0); PG8_BAR; PG8_SCHED;
            PG8_STAGE(PG8_SB(1, 1), b3 + hstep, voffB);
            PG8_WAIT_V(6); PG8_BAR; PG8_MMA(1, 1, At, B1); PG8_BAR;
            }
        }
        if constexpr (ALIGN_EPI) { if (wr == 0) PG8_BAR; }
        if constexpr (!Epi::AFTER_DRAIN) { E(acc, cur, wr, wc, fr, fq); S.done(cur); }
        if (!has_next) break;
#pragma unroll
        for (int a = 0; a < 2; ++a)
#pragma unroll
            for (int b = 0; b < 2; ++b)
#pragma unroll
                for (int m = 0; m < 4; ++m)
#pragma unroll
                    for (int n = 0; n < 2; ++n) acc[a][b][m][n] = (f32x4){0.f, 0.f, 0.f, 0.f};
        cur = nxt; cA = nA; cB = nB; ++ui;
        if constexpr (ALIGN_EPI) { if (wr == 1) PG8_BAR; }
    }
    PG8_WAIT_V(0);
    if constexpr (!ALIGN_EPI) { if (wr == 0) PG8_BAR; }
    PG8_BAR;
    if constexpr (Epi::AFTER_DRAIN) { E.fused(acc, cur, wr, wc, fr, fq, lds, wid, lane); S.done(cur); }
#undef PG8_SA
#undef PG8_SB
#undef PG8_STAGE
#undef PG8_LDA
#undef PG8_LDB
#undef PG8_MMA
#undef PG8_WAIT_V
#undef PG8_WAIT_L
#undef PG8_BAR
#undef PG8_SCHED
}
}

constexpr int NB = 8, SEQ = 4096, M = NB * SEQ, D = 2048, DIN = 11784, NZ = 11776, DEPTH = 2;
constexpr int Z_AQ = 0, Z_AK = 1536, Z_AV = 3072, Z_AG = 4608, Z_SU = 5120, Z_SV = 5632, Z_SG = 6144, Z_MQ = 6656, Z_MK = 7680, Z_MV = 8704, Z_MO = 9728, Z_MG = 10752;
constexpr size_t MiB = 1u << 20;
constexpr size_t WIN_BYTES = (size_t)NZ * D * 2, WOUT_BYTES = (size_t)D * D * 2;
constexpr size_t WS_WIN = 1 * MiB, WS_WOUT = WS_WIN + 2 * WIN_BYTES, WS_GATES = WS_WOUT + 2 * WOUT_BYTES, WS_LSE = WS_GATES + (size_t)M * 8 * 4;
constexpr size_t WS_XB = 114 * MiB, WS_Z = WS_XB + (size_t)M * D * 2, WS_END = WS_Z + (size_t)M * NZ * 2;
static_assert(WS_LSE + (size_t)M * 24 * 4 <= WS_XB, "ws map");
constexpr int LDS_BYTES = 159744;
constexpr float LN_EPS = 1e-5f;

typedef unsigned short bf16;
typedef short bf16x8 __attribute__((ext_vector_type(8)));
typedef float f32x4 __attribute__((ext_vector_type(4)));
typedef unsigned u32x4 __attribute__((ext_vector_type(4)));
typedef unsigned u32x2 __attribute__((ext_vector_type(2)));
typedef short s16x4 __attribute__((ext_vector_type(4)));
#define LAS __attribute__((address_space(3)))

struct Args {
    const float* x; const int* pos; const float* w_in; const float* sgu_ln_g; const float* sgu_ln_b; const float* w_spatial; const float* b_spatial;
    const float* conv_w; const float* conv_b; const float* b_igate; const float* b_fgate; const float* head_norm_g; const float* w_out; const float* ln_g; const float* ln_b;
    float* out; unsigned char* ws;
};

__device__ __forceinline__ float bflo(unsigned w) { return __builtin_bit_cast(float, w << 16); }
__device__ __forceinline__ float bfhi(unsigned w) { return __builtin_bit_cast(float, w & 0xffff0000u); }
__device__ __forceinline__ float bf1(bf16 u) { return __builtin_bit_cast(float, (unsigned)u << 16); }
typedef float f32x2_t __attribute__((ext_vector_type(2)));
typedef __bf16 bf16x2_t __attribute__((ext_vector_type(2)));
__device__ __forceinline__ unsigned pk2(float lo, float hi) { const f32x2_t v = {lo, hi}; return __builtin_bit_cast(unsigned, __builtin_convertvector(v, bf16x2_t)); }
__device__ __forceinline__ unsigned f2bf(float f) { return pk2(f, 0.f) & 0xffffu; }
#define UNPACK8(v, f) do { f[0] = bflo(v.x); f[1] = bfhi(v.x); f[2] = bflo(v.y); f[3] = bfhi(v.y); f[4] = bflo(v.z); f[5] = bfhi(v.z); f[6] = bflo(v.w); f[7] = bfhi(v.w); } while (0)
#define PACK8(f) ((u32x4){pk2(f[0], f[1]), pk2(f[2], f[3]), pk2(f[4], f[5]), pk2(f[6], f[7])})
__device__ __forceinline__ float fexp(float x) { return __builtin_amdgcn_exp2f(x * 1.4426950408889634f); }
__device__ __forceinline__ float flog(float x) { return __builtin_amdgcn_logf(x) * 0.6931471805599453f; }
__device__ __forceinline__ float frcp(float x) { return __builtin_amdgcn_rcpf(x); }
__device__ __forceinline__ float frsq(float x) { return __builtin_amdgcn_rsqf(x); }
__device__ __forceinline__ float silu_f(float y) { return y * frcp(1.f + fexp(-y)); }
__device__ __forceinline__ float sigmoid_f(float y) { return frcp(1.f + fexp(-y)); }
__device__ __forceinline__ float gelu_f(float v) {
    const float av = fabsf(v), t = __builtin_amdgcn_rcpf(av * 0.2316418882f + 1.0f);
    float q = t * 0.5307027145f + (-0.7265760135f); q = q * t + 0.7107068705f; q = q * t + (-0.142248368f); q = q * t + 0.127414796f; q = q * t;
    const float e = __builtin_amdgcn_exp2f((v * v) * (-0.72134752044f));
    const float m = v * (q * e);
    return v < 0.f ? m : v - m;
}
__device__ __forceinline__ f32x4 mfma16(bf16x8 a, bf16x8 b, f32x4 c) { return __builtin_amdgcn_mfma_f32_16x16x32_bf16(a, b, c, 0, 0, 0); }
__device__ __forceinline__ bf16x8 frag_kc(const LAS bf16* base, int ld, int r0, int k0, int lane) {
    return *(const LAS bf16x8*)(base + (r0 + (lane & 15)) * ld + k0 + 8 * (lane >> 4));
}
__device__ __forceinline__ s16x4 tr_rd(const LAS bf16* p) { return __builtin_bit_cast(s16x4, __builtin_amdgcn_ds_read_tr16_b64_v4i16((LAS s16x4*)p)); }
__device__ __forceinline__ bf16x8 frag_ks(const LAS bf16* base, int ld, int k0, int r0, int lane) {
    const int g = lane >> 4, q = (lane & 15) >> 2, p = lane & 3;
    const LAS bf16* a = base + (k0 + 8 * g + q) * ld + r0 + 4 * p;
    const s16x4 lo = tr_rd(a), hi = tr_rd(a + 4 * ld);
    return (bf16x8){lo[0], lo[1], lo[2], lo[3], hi[0], hi[1], hi[2], hi[3]};
}
__device__ __forceinline__ float wave_sum(float v) {
#pragma unroll
    for (int o = 1; o < 64; o <<= 1) v += __shfl_xor(v, o);
    return v;
}
__device__ __forceinline__ float sum16(float v) { v += __shfl_xor(v, 1); v += __shfl_xor(v, 2); v += __shfl_xor(v, 4); v += __shfl_xor(v, 8); return v; }
__device__ __forceinline__ float max16(float v) { v = fmaxf(v, __shfl_xor(v, 1)); v = fmaxf(v, __shfl_xor(v, 2)); v = fmaxf(v, __shfl_xor(v, 4)); v = fmaxf(v, __shfl_xor(v, 8)); return v; }
#define LDS_WAIT() asm volatile("s_waitcnt lgkmcnt(0)" ::: "memory")
#define OPQ(x) asm volatile("" : "+s"(x))
#define GAS __attribute__((address_space(1)))
template <class T> __device__ __forceinline__ T* as_global(T* p) { return (T*)(GAS T*)p; }
typedef const Args __attribute__((address_space(4)))* KArgs;
__device__ __forceinline__ Args load_args(KArgs p) {
#if defined(__HIP_DEVICE_COMPILE__)
    asm volatile("" : "+s"(p)); Args a = *p;
    a.x = as_global(a.x); a.pos = as_global(a.pos); a.w_in = as_global(a.w_in); a.sgu_ln_g = as_global(a.sgu_ln_g); a.sgu_ln_b = as_global(a.sgu_ln_b); a.w_spatial = as_global(a.w_spatial); a.b_spatial = as_global(a.b_spatial);
    a.conv_w = as_global(a.conv_w); a.conv_b = as_global(a.conv_b); a.b_igate = as_global(a.b_igate); a.b_fgate = as_global(a.b_fgate); a.head_norm_g = as_global(a.head_norm_g); a.w_out = as_global(a.w_out);
    a.ln_g = as_global(a.ln_g); a.ln_b = as_global(a.ln_b); a.out = as_global(a.out); a.ws = as_global(a.ws);
    return a;
#else
    return Args{};
#endif
}
__device__ __forceinline__ int opq_tid() { int t = threadIdx.x; asm volatile("" : "+v"(t)); return t; }

__device__ __forceinline__ void transpose_item(const float* W, int ldw, int K, bf16* WT, LAS float* scr, int item, int nblk, int lane) {
    const int kb = item / nblk, nb = item % nblk, k0 = 64 * kb, n0 = 32 * nb;
#pragma unroll 8
    for (int i = 0; i < 32; ++i) { const int kk = 2 * i + (lane >> 5); scr[kk * 33 + (lane & 31)] = W[(size_t)(k0 + kk) * ldw + n0 + (lane & 31)]; }
    LDS_WAIT();
    const int c = lane & 7;
#pragma unroll
    for (int j = 0; j < 4; ++j) { const int n = (lane >> 3) + 8 * j; const LAS float* s = scr + (8 * c) * 33 + n;
        u32x4 o; o.x = pk2(s[0 * 33], s[1 * 33]); o.y = pk2(s[2 * 33], s[3 * 33]); o.z = pk2(s[4 * 33], s[5 * 33]); o.w = pk2(s[6 * 33], s[7 * 33]);
        *(u32x4*)(WT + (size_t)(n0 + n) * K + k0 + 8 * c) = o; }
    LDS_WAIT();
}
__device__ __forceinline__ void load_gate_w(const float* w_in_l, LAS f32x4* wg) {
    for (int idx = opq_tid(); idx < 4096; idx += 512) { const int k = idx >> 1, hh = idx & 1, i = k >> 8, ln = (k & 255) >> 2, e = k & 3;
        wg[((i * 4 + e) * 2 + hh) * 64 + ln] = *(const f32x4*)(w_in_l + (size_t)k * DIN + NZ + 4 * hh); }
}
__device__ __forceinline__ void gate_dots(const f32x4 (&v)[8], const LAS f32x4* wg, float* gates, int lane) {
    f32x4 a0 = {0.f, 0.f, 0.f, 0.f}, a1 = {0.f, 0.f, 0.f, 0.f};
#pragma unroll
    for (int i = 0; i < 8; ++i)
#pragma unroll
        for (int e = 0; e < 4; ++e) { const f32x4 w0 = wg[((i * 4 + e) * 2 + 0) * 64 + lane], w1 = wg[((i * 4 + e) * 2 + 1) * 64 + lane]; a0 += w0 * v[i][e]; a1 += w1 * v[i][e];
            if (e == 3) __builtin_amdgcn_sched_barrier(0); }
#pragma unroll
    for (int e = 0; e < 4; ++e) { a0[e] = wave_sum(a0[e]); a1[e] = wave_sum(a1[e]); }
    if (lane == 0) { *(f32x4*)gates = a0; *(f32x4*)(gates + 4) = a1; }
}
__device__ __forceinline__ void p0_prologue(KArgs kp, LAS unsigned char* lds, int G) {
    const Args A = load_args(kp);
    GAS unsigned char* ws = (GAS unsigned char*)A.ws; OPQ(ws);
    const int tid = opq_tid(), lane = tid & 63, wave = tid >> 6;
    const int gw = blockIdx.x * 8 + wave, NGW = G * 8;
    LAS float* scr = (LAS float*)(lds + wave * 16384);
    constexpr int I_IN = (D / 64) * (NZ / 32), I_OUT = (D / 64) * (D / 32);
    for (int it = gw; it < 2 * (I_IN + I_OUT); it += NGW) {
        int r = it; const int l = r / (I_IN + I_OUT); r -= l * (I_IN + I_OUT);
        if (r < I_IN) transpose_item(A.w_in + (size_t)l * D * DIN, DIN, D, (bf16*)(ws + WS_WIN + l * WIN_BYTES), scr, r, NZ / 32, lane);
        else transpose_item(A.w_out + (size_t)l * D * D, D, D, (bf16*)(ws + WS_WOUT + l * WOUT_BYTES), scr, r - I_IN, D / 32, lane);
    }
    __syncthreads();
    LAS f32x4* wg = (LAS f32x4*)lds;
    load_gate_w(A.w_in, wg);
    __syncthreads();
    bf16* XB = (bf16*)(ws + WS_XB); float* GT = (float*)(ws + WS_GATES);
    for (int m = gw; m < M; m += NGW) {
        const f32x4* xr = (const f32x4*)(A.x + (size_t)m * D) + lane;
        f32x4 v[8];
#pragma unroll
        for (int i = 0; i < 8; ++i) v[i] = xr[64 * i];
        u32x2* o = (u32x2*)(XB + (size_t)m * D) + lane;
#pragma unroll
        for (int i = 0; i < 8; ++i) o[64 * i] = (u32x2){pk2(v[i][0], v[i][1]), pk2(v[i][2], v[i][3])};
        gate_dots(v, wg, GT + (size_t)m * 8, lane);
    }
    __syncthreads();
}

__device__ __forceinline__ void conv_unit(KArgs kp, int l, int u) {
    const Args A = load_args(kp);
    GAS unsigned char* ws = (GAS unsigned char*)A.ws; OPQ(ws); OPQ(l);
    const int tid = opq_tid(), cgp = tid & 255, half = tid >> 8, c0 = 8 * cgp, r0 = 32 * u + 16 * half;
    const bf16* Z = (const bf16*)(ws + WS_Z); bf16* Q = (bf16*)(ws + WS_XB);
    const float* cw = A.conv_w + (size_t)l * 4 * 2048 + c0; const float* cb = A.conv_b + (size_t)l * 2048 + c0;
    const bf16* zp = Z + (size_t)r0 * NZ + Z_MQ + c0;
    u32x4 rows[19];
    const bool hist = (r0 & (SEQ - 1)) != 0;
#pragma unroll
    for (int t = 0; t < 3; ++t) { rows[t] = (u32x4){0u, 0u, 0u, 0u}; if (hist) rows[t] = *(const u32x4*)(zp + (size_t)(t - 3) * NZ); }
#pragma unroll
    for (int t = 0; t < 16; ++t) rows[3 + t] = *(const u32x4*)(zp + (size_t)t * NZ);
    float w0[8], w1[8], w2[8], w3[8], bb[8], x3[8], x2[8], x1[8], cur[8], y[8];
#pragma unroll
    for (int e = 0; e < 8; ++e) { w0[e] = cw[e]; w1[e] = cw[2048 + e]; w2[e] = cw[4096 + e]; w3[e] = cw[6144 + e]; bb[e] = cb[e]; }
    UNPACK8(rows[0], x3); UNPACK8(rows[1], x2); UNPACK8(rows[2], x1);
    const float sc = (c0 >= 1024) ? 0.0625f : 1.f;
#pragma unroll
    for (int t = 0; t < 16; ++t) {
        UNPACK8(rows[3 + t], cur);
#pragma unroll
        for (int e = 0; e < 8; ++e) { const float sv = bb[e] + w0[e] * x3[e] + w1[e] * x2[e] + w2[e] * x1[e] + w3[e] * cur[e]; y[e] = silu_f(sv) * sc; x3[e] = x2[e]; x2[e] = x1[e]; x1[e] = cur[e]; }
        *(u32x4*)(Q + (size_t)(r0 + t) * 2048 + c0) = PACK8(y);
    }
}

constexpr int SGU_VLD = 520;
__device__ __forceinline__ void sgu_unit(KArgs kp, int l, int u, LAS unsigned char* lds, bool dry = false) {
    const Args A = load_args(kp);
    GAS unsigned char* ws = (GAS unsigned char*)A.ws; OPQ(ws); OPQ(l);
    const int tid = opq_tid(), lane = tid & 63, w = tid >> 6;
    bf16* Z = (bf16*)(ws + WS_Z);
    LAS bf16* VN = (LAS bf16*)lds;
    const size_t t0 = (size_t)u * 128;
    {
        u32x4 raw[16];
#pragma unroll
        for (int tt = 0; tt < 16; ++tt) raw[tt] = *(const u32x4*)(Z + (t0 + 16 * w + tt) * NZ + Z_SV + 8 * lane);
#pragma unroll
        for (int tt = 0; tt < 16; ++tt) *(LAS u32x4*)(VN + (16 * w + tt) * SGU_VLD + 8 * lane) = raw[tt];
        float g8[8], b8[8];
#pragma unroll
        for (int e = 0; e < 8; ++e) { g8[e] = A.sgu_ln_g[l * 512 + 8 * lane + e]; b8[e] = A.sgu_ln_b[l * 512 + 8 * lane + e]; }
#pragma unroll 1
        for (int tt = 0; tt < 16; ++tt) { const int t = 16 * w + tt;
            const u32x4 rv = *(const LAS u32x4*)(VN + t * SGU_VLD + 8 * lane); float f[8]; UNPACK8(rv, f);
            float sm = 0.f;
#pragma unroll
            for (int e = 0; e < 8; ++e) { f[e] = gelu_f(f[e]); sm += f[e]; }
            const float mean = wave_sum(sm) * (1.f / 512.f); float q = 0.f;
#pragma unroll
            for (int e = 0; e < 8; ++e) { f[e] -= mean; q += f[e] * f[e]; }
            const float rstd = frsq(wave_sum(q) * (1.f / 512.f) + LN_EPS);
#pragma unroll
            for (int e = 0; e < 8; ++e) f[e] = f[e] * rstd * g8[e] + b8[e];
            *(LAS u32x4*)(VN + t * SGU_VLD + 8 * lane) = PACK8(f);
        }
    }
    __syncthreads();
    const int fr = lane & 15, fq = lane >> 4, trow = 16 * w + fr;
    bf16* zr = Z + (t0 + trow) * NZ;
#pragma unroll 1
    for (int g = 0; g < 4; ++g) {
        f32x4 acc[8];
#pragma unroll
        for (int mt = 0; mt < 8; ++mt) acc[mt] = (f32x4){0.f, 0.f, 0.f, 0.f};
        u32x2 su2[8], sg2[8];
#pragma unroll
        for (int mt = 0; mt < 8; ++mt) { su2[mt] = *(const u32x2*)(zr + Z_SU + g * 128 + 16 * mt + 4 * fq); sg2[mt] = *(const u32x2*)(zr + Z_SG + g * 128 + 16 * mt + 4 * fq); }
        const float* wrow = A.w_spatial + (((size_t)l * 4 + g) * 128 + trow) * 128;
        const float bs = A.b_spatial[((size_t)l * 4 + g) * 128 + trow];
        for (int ks = 0; ks <= (w >> 1); ++ks) {
            const int s0 = 32 * ks + 8 * fq;
            const f32x4 wa = *(const f32x4*)(wrow + s0), wb = *(const f32x4*)(wrow + s0 + 4);
            float wf[8] = {wa[0], wa[1], wa[2], wa[3], wb[0], wb[1], wb[2], wb[3]};
#pragma unroll
            for (int e = 0; e < 8; ++e) wf[e] = (s0 + e <= trow) ? wf[e] : 0.f;
            const u32x4 bp = PACK8(wf); const bf16x8 bfrag = __builtin_bit_cast(bf16x8, bp);
#pragma unroll
            for (int mt = 0; mt < 8; ++mt) acc[mt] = mfma16(frag_ks(VN, SGU_VLD, 32 * ks, g * 128 + 16 * mt, lane), bfrag, acc[mt]);
        }
#pragma unroll
        for (int mt = 0; mt < 8; ++mt) {
            const float u0 = gelu_f(bflo(su2[mt].x)), u1 = gelu_f(bfhi(su2[mt].x)), u2 = gelu_f(bflo(su2[mt].y)), u3 = gelu_f(bfhi(su2[mt].y));
            const float g0 = silu_f(bflo(sg2[mt].x)), g1 = silu_f(bfhi(sg2[mt].x)), g2 = silu_f(bflo(sg2[mt].y)), g3 = silu_f(bfhi(sg2[mt].y));
            const u32x2 o = {pk2(u0 * (acc[mt][0] + bs) * g0, u1 * (acc[mt][1] + bs) * g1), pk2(u2 * (acc[mt][2] + bs) * g2, u3 * (acc[mt][3] + bs) * g3)};
            *(u32x2*)(dry ? (bf16*)ws + tid * 64 : zr + Z_SU + g * 128 + 16 * mt + 4 * fq) = o;
        }
    }
    __syncthreads();
}

constexpr int AT_LD = 72, AT_PLD = 168;
constexpr int AT_Q = 0, AT_K = AT_Q + 128 * AT_LD * 2, AT_V = AT_K + 256 * AT_LD * 2, AT_P = AT_V + 272 * AT_LD * 2, AT_END = AT_P + 8 * 16 * AT_PLD * 2;
static_assert(AT_END <= LDS_BYTES, "attention LDS");
struct AttnId { int g, b, h, r, n, d, hc; };
__device__ __forceinline__ AttnId attn_decode(int slot) {
    const int u = (slot & ~63) | ((slot & 7) << 3) | ((slot >> 3) & 7);
    AttnId a; a.g = u >> 11; const int rem = u & 2047; a.b = rem >> 8; a.h = (rem >> 5) & 7; const int rn = rem & 31;
    const int dsh = 2 * a.g, nbsh = 5 - dsh; a.d = 1 << dsh; a.r = rn >> nbsh; a.n = rn & ((1 << nbsh) - 1); a.hc = (a.g * 8 + a.h) * 64; return a;
}
__device__ __forceinline__ void attn_issue(const bf16* Z, const int* posp, const AttnId& a, int tid, u32x4 (&pr)[11], int& ppos) {
    const size_t tokb = (size_t)a.b * SEQ;
#pragma unroll
    for (int i = 0; i < 11; ++i) pr[i] = (u32x4){0u, 0u, 0u, 0u};
    ppos = 0;
    if (tid < 384) {
        const int isK = tid >= 128, idx = isK ? tid - 128 : tid, isub = isK ? 128 * (a.n - 1) + idx : 128 * a.n + idx;
        if (isub >= 0) { const size_t tok = tokb + (size_t)isub * a.d + a.r; const bf16* src = Z + tok * NZ + (isK ? Z_AK : Z_AQ) + a.hc;
            pr[0] = *(const u32x4*)src; pr[1] = *(const u32x4*)(src + 8); ppos = posp[tok]; }
    }
#pragma unroll
    for (int k = 0; k < 5; ++k) { const int idx = tid + 512 * k;
        if (idx < 2304) { const int row = idx / 6, ch = 2 + idx % 6, isK = row >= 128, ri = isK ? row - 128 : row, isub = isK ? 128 * (a.n - 1) + ri : 128 * a.n + ri;
            if (isub >= 0) pr[2 + k] = *(const u32x4*)(Z + (tokb + (size_t)isub * a.d + a.r) * NZ + (isK ? Z_AK : Z_AQ) + a.hc + 8 * ch); } }
#pragma unroll
    for (int k = 0; k < 4; ++k) { const int idx = tid + 512 * k, row = idx >> 3, ch = idx & 7, isub = 128 * (a.n - 1) + row;
        if (isub >= 0) pr[7 + k] = *(const u32x4*)(Z + (tokb + (size_t)isub * a.d + a.r) * NZ + Z_AV + a.hc + 8 * ch); }
}
__device__ __forceinline__ void attn_commit(LAS unsigned char* lds, int tid, const u32x4 (&pr)[11], int ppos) {
    LAS bf16* Qs = (LAS bf16*)(lds + AT_Q); LAS bf16* Ks = (LAS bf16*)(lds + AT_K); LAS bf16* Vs = (LAS bf16*)(lds + AT_V);
    if (tid < 384) {
        const int isK = tid >= 128, idx = isK ? tid - 128 : tid;
        LAS bf16* dst = (isK ? Ks : Qs) + idx * AT_LD;
        float t1[8], t2[8]; UNPACK8(pr[0], t1); UNPACK8(pr[1], t2);
        const float pos = (float)ppos;
        const float invf[8] = {1.0f, 0.19392274474868576f, 0.03760603093086393f, 0.007292664737217109f, 0.001414213562373095f, 0.0002742481756762073f, 5.318295896944988e-05f, 1.031338537721246e-05f};
#pragma unroll
        for (int i = 0; i < 8; ++i) {
            const float ang = pos * invf[i], k = rintf(ang * 0.15915494309189535f);
            float rr = fmaf(-k, 6.2831854820251465f, ang); rr = fmaf(-k, -1.7484555e-7f, rr);
            const float cs = __cosf(rr), sn = __sinf(rr);
            const float a1 = t1[i] * cs - t2[i] * sn, a2 = t2[i] * cs + t1[i] * sn; t1[i] = a1; t2[i] = a2;
        }
        *(LAS u32x4*)dst = PACK8(t1); *(LAS u32x4*)(dst + 8) = PACK8(t2);
    }
#pragma unroll
    for (int k = 0; k < 5; ++k) { const int idx = tid + 512 * k;
        if (idx < 2304) { const int row = idx / 6, ch = 2 + idx % 6, isK = row >= 128, ri = isK ? row - 128 : row;
            *(LAS u32x4*)((isK ? Ks : Qs) + ri * AT_LD + 8 * ch) = pr[2 + k]; } }
#pragma unroll
    for (int k = 0; k < 4; ++k) { const int idx = tid + 512 * k, row = idx >> 3, ch = idx & 7; *(LAS u32x4*)(Vs + row * AT_LD + 8 * ch) = pr[7 + k]; }
}
__device__ __forceinline__ bf16x8 frag_ks_pair(const LAS bf16* base, int ld, int k0, int r0, int lane) {
    const int g = lane >> 4, q = (lane & 15) >> 2, p = lane & 3;
    const LAS bf16* a = base + (k0 + 4 * g + q) * ld + r0 + 4 * p;
    const s16x4 lo = tr_rd(a), hi = tr_rd(a + 16 * ld);
    return (bf16x8){lo[0], lo[1], lo[2], lo[3], hi[0], hi[1], hi[2], hi[3]};
}
__device__ __forceinline__ void attn_compute(bf16* Z, float* LSE, const AttnId& a, LAS unsigned char* lds, int tid, bool dry, unsigned char* ws) {
    const int lane = tid & 63, w = tid >> 6, fr = lane & 15, fq = lane >> 4, n = a.n;
    LAS bf16* Qs = (LAS bf16*)(lds + AT_Q); LAS bf16* Ks = (LAS bf16*)(lds + AT_K); LAS bf16* Vs = (LAS bf16*)(lds + AT_V);
    const bf16x8 q0 = frag_kc(Qs, AT_LD, 16 * w, 0, lane), q1 = frag_kc(Qs, AT_LD, 16 * w, 32, lane);
    f32x4 s[10];
    float mx = -INFINITY;
#pragma unroll
    for (int tt = 0; tt < 9; ++tt) { const int kt = w + tt;
        f32x4 acc = {0.f, 0.f, 0.f, 0.f};
        acc = mfma16(frag_kc(Ks, AT_LD, 16 * kt, 0, lane), q0, acc); acc = mfma16(frag_kc(Ks, AT_LD, 16 * kt, 32, lane), q1, acc);
        const bool tile_ok = (n > 0) || (kt >= 8);
#pragma unroll
        for (int j = 0; j < 4; ++j) { const int dl = fr - 4 * fq - j; const bool ok = tile_ok && (tt == 0 ? dl <= 0 : (tt == 8 ? dl >= 0 : true));
            acc[j] = ok ? acc[j] * 0.125f : -INFINITY; mx = fmaxf(mx, acc[j]); }
        s[tt] = acc;
    }
    mx = fmaxf(mx, __shfl_xor(mx, 16)); mx = fmaxf(mx, __shfl_xor(mx, 32));
    float ls = 0.f;
#pragma unroll
    for (int tt = 0; tt < 9; ++tt)
#pragma unroll
        for (int j = 0; j < 4; ++j) { const float p = fexp(s[tt][j] - mx); ls += p; s[tt][j] = p; }
    s[9] = (f32x4){0.f, 0.f, 0.f, 0.f};
    ls += __shfl_xor(ls, 16); ls += __shfl_xor(ls, 32);
    f32x4 o[4];
#pragma unroll
    for (int nt = 0; nt < 4; ++nt) o[nt] = (f32x4){0.f, 0.f, 0.f, 0.f};
#pragma unroll
    for (int k2 = 0; k2 < 5; ++k2) {
        const u32x4 pp = {pk2(s[2 * k2][0], s[2 * k2][1]), pk2(s[2 * k2][2], s[2 * k2][3]), pk2(s[2 * k2 + 1][0], s[2 * k2 + 1][1]), pk2(s[2 * k2 + 1][2], s[2 * k2 + 1][3])};
        const bf16x8 pf = __builtin_bit_cast(bf16x8, pp);
#pragma unroll
        for (int nt = 0; nt < 4; ++nt) o[nt] = mfma16(frag_ks_pair(Vs, AT_LD, 16 * (w + 2 * k2), 16 * nt, lane), pf, o[nt]); }
    const int isub = 128 * n + 16 * w + fr; const size_t tok = (size_t)a.b * SEQ + (size_t)isub * a.d + a.r; const float inv = frcp(ls);
    bf16* orow = dry ? (bf16*)ws + tid * 64 : Z + tok * NZ + Z_AQ + a.hc;
#pragma unroll
    for (int nt = 0; nt < 4; ++nt) *(u32x2*)(orow + 16 * nt + 4 * fq) = (u32x2){pk2(o[nt][0] * inv, o[nt][1] * inv), pk2(o[nt][2] * inv, o[nt][3] * inv)};
    if (fq == 0) (dry ? (float*)ws + 65536 + tid : LSE + tok * 24 + a.g * 8 + a.h)[0] = mx + flog(ls);
}
__device__ __forceinline__ void attn_phase(KArgs kp, LAS unsigned char* lds, int G, bool dry = false) {
    const Args A = load_args(kp);
    GAS unsigned char* ws = (GAS unsigned char*)A.ws; OPQ(ws);
    const int tid = opq_tid();
    bf16* Z = (bf16*)(ws + WS_Z); float* LSE = (float*)(ws + WS_LSE);
    constexpr int N_ATT = 6144;
    if (tid < 128) { const int row = 256 + (tid >> 3), ch = tid & 7; unsigned z = 0u; asm volatile("" : "+v"(z)); *(LAS u32x4*)((LAS bf16*)(lds + AT_V) + row * AT_LD + 8 * ch) = (u32x4){z, z, z, z}; }
    u32x4 pr[11]; int ppos;
    int it = blockIdx.x;
    AttnId cur = attn_decode(it < N_ATT ? it : 0);
    if (it < N_ATT) attn_issue(Z, A.pos, cur, tid, pr, ppos);
    for (; it < N_ATT; it += G) {
        attn_commit(lds, tid, pr, ppos);
        __syncthreads();
        const int nx = it + G;
        const AttnId nxt = attn_decode(nx < N_ATT ? nx : 0);
        if (nx < N_ATT) attn_issue(Z, A.pos, nxt, tid, pr, ppos);
        attn_compute(Z, LSE, cur, lds, tid, dry, (unsigned char*)ws);
        __syncthreads();
        cur = nxt;
    }
}

constexpr int ML_KLD = 264, ML_VLD = 48, ML_CLD = 264;
constexpr int ML_K = 0, ML_V = ML_K + 128 * ML_KLD * 2, ML_VW = ML_V + 128 * ML_VLD * 2, ML_C = ML_VW + 128 * ML_VLD * 2, ML_S = ML_C + 48 * ML_CLD * 2, ML_SBUF = 6 * 128 * 4, ML_G = ML_S + 2 * ML_SBUF, ML_END = ML_G + 4096 * 8;
static_assert(ML_END <= LDS_BYTES - 64, "mlstm LDS");
__device__ __forceinline__ float mlstm_scalars(LAS float* sb, float ig0, float ig1, float f0, float f1, float mcar, int lane) {
    const float lf0 = fminf(f0, 0.f) - log1pf(fexp(-fabsf(f0))), lf1 = fminf(f1, 0.f) - log1pf(fexp(-fabsf(f1)));
    const float pr = lf0 + lf1; float inc = pr;
#pragma unroll
    for (int o = 1; o < 64; o <<= 1) { const float t = __shfl_up(inc, o); if (lane >= o) inc += t; }
    const float b0 = inc - pr + lf0, b1 = inc;
    const float u0 = ig0 - b0, u1 = ig1 - b1;
    float pmx = fmaxf(u0, u1);
#pragma unroll
    for (int o = 1; o < 64; o <<= 1) { const float t = __shfl_up(pmx, o); if (lane >= o) pmx = fmaxf(pmx, t); }
    float ex = __shfl_up(pmx, 1); if (lane == 0) ex = -INFINITY;
    const float pm0 = fmaxf(ex, u0), pm1 = pmx;
    const float mt0 = b0 + fmaxf(mcar, pm0), mt1 = b1 + fmaxf(mcar, pm1);
    const float gtot = __shfl(b1, 63), pmall = __shfl(pm1, 63);
    const float mnew = fmaxf(gtot + mcar, gtot + pmall);
    sb[2 * lane] = b0; sb[2 * lane + 1] = b1; sb[128 + 2 * lane] = u0; sb[128 + 2 * lane + 1] = u1; sb[256 + 2 * lane] = mt0; sb[256 + 2 * lane + 1] = mt1;
    sb[384 + 2 * lane] = fexp(b0 + mcar - mt0); sb[384 + 2 * lane + 1] = fexp(b1 + mcar - mt1);
    sb[512 + 2 * lane] = fexp(gtot + u0 - mnew); sb[512 + 2 * lane + 1] = fexp(gtot + u1 - mnew);
    if (lane == 0) sb[640] = fexp(gtot + mcar - mnew);
    return mnew;
}
__device__ __forceinline__ void mlstm_unit(KArgs kp, int l, int u, LAS unsigned char* lds, bool dry = false) {
    const Args A = load_args(kp);
    GAS unsigned char* ws = (GAS unsigned char*)A.ws; OPQ(ws); OPQ(l);
    const int tid = opq_tid(), lane = tid & 63, w = tid >> 6, fr = lane & 15, fq = lane >> 4;
    const int pr_ = (u & 7) * 4 + (u >> 6), js = (u >> 3) & 7, b = pr_ >> 2, h = pr_ & 3;
    bf16* Z = (bf16*)(ws + WS_Z); const bf16* QKC = (const bf16*)(ws + WS_XB); const float* GT = (const float*)(ws + WS_GATES);
    LAS bf16* Ks = (LAS bf16*)(lds + ML_K); LAS bf16* Vs = (LAS bf16*)(lds + ML_V); LAS bf16* Vw = (LAS bf16*)(lds + ML_VW); LAS bf16* CsT = (LAS bf16*)(lds + ML_C);
    const float bi = A.b_igate[l * 4 + h], bfg = A.b_fgate[l * 4 + h];
    f32x4 st[2][3];
#pragma unroll
    for (int a = 0; a < 2; ++a)
#pragma unroll
        for (int c = 0; c < 3; ++c) st[a][c] = (f32x4){0.f, 0.f, 0.f, 0.f};
    float mcar = -INFINITY;
    const size_t tb = (size_t)b * SEQ;
    const int vs = tid >> 2, vch = tid & 3;
    u32x4 kreg[8]; u32x4 vraw; bf16x8 qf[8];
    LAS f32x2_t* gl = (LAS f32x2_t*)(lds + ML_G);
    {   float ga[8], gb[8];
#pragma unroll
        for (int k = 0; k < 8; ++k) { const float* gp = GT + (tb + tid + 512 * k) * 8; ga[k] = gp[h]; gb[k] = gp[4 + h]; }
#pragma unroll
        for (int k = 0; k < 8; ++k) gl[tid + 512 * k] = (f32x2_t){ga[k] + bi, gb[k] + bfg};
    }
#pragma unroll
    for (int k = 0; k < 8; ++k) { const int idx = tid + 512 * k, sr = idx >> 5, ch = idx & 31; kreg[k] = *(const u32x4*)(QKC + (tb + sr) * 2048 + 1024 + h * 256 + 8 * ch); }
    vraw = *(const u32x4*)(Z + (tb + vs) * NZ + Z_MV + h * 256 + 32 * js + 8 * vch);
    { const bf16* qp = QKC + (tb + 16 * w + fr) * 2048 + h * 256 + 8 * fq;
#pragma unroll
      for (int ks = 0; ks < 8; ++ks) qf[ks] = __builtin_bit_cast(bf16x8, *(const u32x4*)(qp + 32 * ks)); }
    __syncthreads();
    if (w == 0) { const f32x2_t g0 = gl[2 * lane], g1 = gl[2 * lane + 1]; mcar = mlstm_scalars((LAS float*)(lds + ML_S), g0.x, g1.x, g0.y, g1.y, mcar, lane); }
    __syncthreads();
#pragma unroll 1
    for (int c = 0; c < 32; ++c) {
        const size_t t0 = tb + (size_t)c * 128, t1 = t0 + 128;
        const bool more = c < 31;
        LAS float* sb = (LAS float*)(lds + ML_S + (c & 1) * ML_SBUF); LAS float* sbn = (LAS float*)(lds + ML_S + ((c + 1) & 1) * ML_SBUF);
#pragma unroll
        for (int k = 0; k < 8; ++k) { const int idx = tid + 512 * k, sr = idx >> 5, ch = idx & 31; *(LAS u32x4*)(Ks + sr * ML_KLD + 8 * ch) = kreg[k]; }
        *(LAS u32x4*)(Vs + vs * ML_VLD + 8 * vch) = vraw;
        {   const float wt = sb[512 + vs]; float f[8]; UNPACK8(vraw, f);
#pragma unroll
            for (int e = 0; e < 8; ++e) f[e] *= wt;
            *(LAS u32x4*)(Vw + vs * ML_VLD + 8 * vch) = PACK8(f); }
        if (tid < 256) { const int sr = tid >> 1, ch = 4 + (tid & 1);
            *(LAS u32x4*)(Vs + sr * ML_VLD + 8 * ch) = (u32x4){(ch == 4) ? 0x3f80u : 0u, 0u, 0u, 0u};
            *(LAS u32x4*)(Vw + sr * ML_VLD + 8 * ch) = (u32x4){(ch == 4) ? f2bf(sb[512 + sr]) : 0u, 0u, 0u, 0u}; }
        __syncthreads();
        if (more) {
#pragma unroll
            for (int k = 0; k < 8; ++k) { const int idx = tid + 512 * k, sr = idx >> 5, ch = idx & 31; kreg[k] = *(const u32x4*)(QKC + (t1 + sr) * 2048 + 1024 + h * 256 + 8 * ch); }
            vraw = *(const u32x4*)(Z + (t1 + vs) * NZ + Z_MV + h * 256 + 32 * js + 8 * vch);
        }
        const int tq = 16 * w + fr;
        const float btq = sb[tq], mtq = sb[256 + tq], itr = sb[384 + tq];
        f32x4 num[3], qc[3];
#pragma unroll
        for (int nt = 0; nt < 3; ++nt) { num[nt] = (f32x4){0.f, 0.f, 0.f, 0.f}; qc[nt] = (f32x4){0.f, 0.f, 0.f, 0.f}; }
#pragma unroll 1
        for (int k2 = 0; k2 <= (w >> 1); ++k2) {
            u32x4 pp;
            {   f32x4 a0 = {0.f, 0.f, 0.f, 0.f};
                bf16x8 kf[8];
#pragma unroll
                for (int ks = 0; ks < 8; ++ks) kf[ks] = frag_kc(Ks, ML_KLD, 32 * k2, 32 * ks, lane);
                __builtin_amdgcn_sched_barrier(0);
#pragma unroll
                for (int ks = 0; ks < 8; ++ks) a0 = mfma16(kf[ks], qf[ks], a0);
                const f32x4 us = *(const LAS f32x4*)(sb + 128 + 32 * k2 + 4 * fq);
                const bool diag = (2 * k2 == w);
                float p[4];
#pragma unroll
                for (int j = 0; j < 4; ++j) p[j] = (!diag || 4 * fq + j <= fr) ? a0[j] * fexp(btq + us[j] - mtq) : 0.f;
                pp.x = pk2(p[0], p[1]); pp.y = pk2(p[2], p[3]); }
            if (2 * k2 + 1 <= w) {
                f32x4 a1 = {0.f, 0.f, 0.f, 0.f};
                bf16x8 kf[8];
#pragma unroll
                for (int ks = 0; ks < 8; ++ks) kf[ks] = frag_kc(Ks, ML_KLD, 32 * k2 + 16, 32 * ks, lane);
                __builtin_amdgcn_sched_barrier(0);
#pragma unroll
                for (int ks = 0; ks < 8; ++ks) a1 = mfma16(kf[ks], qf[ks], a1);
                const f32x4 us = *(const LAS f32x4*)(sb + 128 + 32 * k2 + 16 + 4 * fq);
                const bool diag = (2 * k2 + 1 == w);
                float p[4];
#pragma unroll
                for (int j = 0; j < 4; ++j) p[j] = (!diag || 4 * fq + j <= fr) ? a1[j] * fexp(btq + us[j] - mtq) : 0.f;
                pp.z = pk2(p[0], p[1]); pp.w = pk2(p[2], p[3]);
            } else { pp.z = 0u; pp.w = 0u; }
            const bf16x8 pf = __builtin_bit_cast(bf16x8, pp);
#pragma unroll
            for (int nt = 0; nt < 3; ++nt) num[nt] = mfma16(frag_ks_pair(Vs, ML_VLD, 32 * k2, 16 * nt, lane), pf, num[nt]);
        }
        if (more && w == 0) { const f32x2_t g0 = gl[(c + 1) * 128 + 2 * lane], g1 = gl[(c + 1) * 128 + 2 * lane + 1]; mcar = mlstm_scalars(sbn, g0.x, g1.x, g0.y, g1.y, mcar, lane); }
        if (c > 0) {
#pragma unroll
            for (int kh = 0; kh < 4; ++kh) {
                bf16x8 cf[2][3];
#pragma unroll
                for (int k1 = 0; k1 < 2; ++k1)
#pragma unroll
                    for (int nt = 0; nt < 3; ++nt) cf[k1][nt] = frag_kc(CsT, ML_CLD, 16 * nt, 32 * (2 * kh + k1), lane);
                __builtin_amdgcn_sched_barrier(0);
#pragma unroll
                for (int k1 = 0; k1 < 2; ++k1)
#pragma unroll
                    for (int nt = 0; nt < 3; ++nt) qc[nt] = mfma16(cf[k1][nt], qf[2 * kh + k1], qc[nt]);
            }
        }
        if (more) { const bf16* qp = QKC + (t1 + 16 * w + fr) * 2048 + h * 256 + 8 * fq;
#pragma unroll
            for (int ks = 0; ks < 8; ++ks) qf[ks] = __builtin_bit_cast(bf16x8, *(const u32x4*)(qp + 32 * ks)); }
        {
            const float dd = num[2][0] + itr * qc[2][0]; const float den = __shfl(dd, fr);
            const float inv = frcp(fmaxf(fabsf(den), fexp(-mtq)));
            bf16* hp = dry ? (bf16*)ws + tid * 64 : Z + (t0 + tq) * NZ + Z_MV + h * 256 + 32 * js;
#pragma unroll
            for (int nt = 0; nt < 2; ++nt) *(u32x2*)(hp + 16 * nt + 4 * fq) = (u32x2){pk2((num[nt][0] + itr * qc[nt][0]) * inv, (num[nt][1] + itr * qc[nt][1]) * inv), pk2((num[nt][2] + itr * qc[nt][2]) * inv, (num[nt][3] + itr * qc[nt][3]) * inv)};
        }
        {
            const float dec = sb[640];
#pragma unroll
            for (int a = 0; a < 2; ++a)
#pragma unroll
                for (int nt = 0; nt < 3; ++nt) st[a][nt] = st[a][nt] * dec;
#pragma unroll
            for (int ks = 0; ks < 4; ++ks) {
                bf16x8 bfr[3];
#pragma unroll
                for (int nt = 0; nt < 3; ++nt) bfr[nt] = frag_ks(Vw, ML_VLD, 32 * ks, 16 * nt, lane);
#pragma unroll
                for (int a = 0; a < 2; ++a) { const bf16x8 af = frag_ks(Ks, ML_KLD, 32 * ks, 32 * w + 16 * a, lane);
#pragma unroll
                    for (int nt = 0; nt < 3; ++nt) st[a][nt] = mfma16(af, bfr[nt], st[a][nt]); }
            }
        }
        __syncthreads();
#pragma unroll
        for (int a = 0; a < 2; ++a)
#pragma unroll
            for (int nt = 0; nt < 3; ++nt)
                *(LAS u32x2*)(CsT + (16 * nt + fr) * ML_CLD + 32 * w + 16 * a + 4 * fq) = (u32x2){pk2(st[a][nt][0], st[a][nt][1]), pk2(st[a][nt][2], st[a][nt][3])};
    }
    __syncthreads();
}

__device__ __forceinline__ void finish_phase(KArgs kp, int l, int G) {
    const Args A = load_args(kp);
    GAS unsigned char* ws = (GAS unsigned char*)A.ws; OPQ(ws); OPQ(l);
    const int tid = opq_tid(), lane = tid & 63, wave = tid >> 6, gw = blockIdx.x * 8 + wave, NGW = G * 8;
    const bf16* Z = (const bf16*)(ws + WS_Z); const float* LSE = (const float*)(ws + WS_LSE); bf16* MIX = (bf16*)(ws + WS_XB);
    float hg[16];
#pragma unroll
    for (int e = 0; e < 16; ++e) hg[e] = A.head_norm_g[l * 1024 + 16 * lane + e];
    for (int m = gw; m < M; m += NGW) {
        const bf16* zr = Z + (size_t)m * NZ; bf16* mr = MIX + (size_t)m * 2048;
        {
            const int hh = lane >> 3; const float* lp = LSE + (size_t)m * 24 + hh;
            const float l0 = lp[0], l1 = lp[8], l2 = lp[16], mx = fmaxf(l0, fmaxf(l1, l2));
            float e0 = fexp(l0 - mx), e1 = fexp(l1 - mx), e2 = fexp(l2 - mx); const float inv = frcp(e0 + e1 + e2); e0 *= inv; e1 *= inv; e2 *= inv;
            const u32x4 r0 = *(const u32x4*)(zr + Z_AQ + 8 * lane), r1 = *(const u32x4*)(zr + Z_AQ + 512 + 8 * lane), r2 = *(const u32x4*)(zr + Z_AQ + 1024 + 8 * lane), rg = *(const u32x4*)(zr + Z_AG + 8 * lane);
            float o0[8], o1[8], o2[8], gg[8], y[8]; UNPACK8(r0, o0); UNPACK8(r1, o1); UNPACK8(r2, o2); UNPACK8(rg, gg);
#pragma unroll
            for (int e = 0; e < 8; ++e) y[e] = (e0 * o0[e] + e1 * o1[e] + e2 * o2[e]) * silu_f(gg[e]);
            *(u32x4*)(mr + 8 * lane) = PACK8(y);
        }
        *(u32x4*)(mr + 512 + 8 * lane) = *(const u32x4*)(zr + Z_SU + 8 * lane);
        {
            float x[16], gm[16];
#pragma unroll
            for (int c2 = 0; c2 < 2; ++c2) { const u32x4 hv = *(const u32x4*)(zr + Z_MV + 16 * lane + 8 * c2), ov = *(const u32x4*)(zr + Z_MO + 16 * lane + 8 * c2), gv = *(const u32x4*)(zr + Z_MG + 16 * lane + 8 * c2);
                float hf[8], of[8], gf[8]; UNPACK8(hv, hf); UNPACK8(ov, of); UNPACK8(gv, gf);
#pragma unroll
                for (int e = 0; e < 8; ++e) { x[8 * c2 + e] = hf[e] * sigmoid_f(of[e]); gm[8 * c2 + e] = gf[e]; } }
            float s = 0.f;
#pragma unroll
            for (int e = 0; e < 16; ++e) s += x[e];
            const float mean = sum16(s) * (1.f / 256.f); float q = 0.f;
#pragma unroll
            for (int e = 0; e < 16; ++e) { x[e] -= mean; q += x[e] * x[e]; }
            const float rstd = frsq(sum16(q) * (1.f / 256.f) + LN_EPS);
            float y0[8], y1[8];
#pragma unroll
            for (int e = 0; e < 8; ++e) { y0[e] = x[e] * rstd * hg[e] * silu_f(gm[e]); y1[e] = x[8 + e] * rstd * hg[8 + e] * silu_f(gm[8 + e]); }
            *(u32x4*)(mr + 1024 + 16 * lane) = PACK8(y0); *(u32x4*)(mr + 1024 + 16 * lane + 8) = PACK8(y1);
        }
    }
}

__device__ __forceinline__ void ln_phase(KArgs kp, int l, int G, LAS unsigned char* lds) {
    const Args A = load_args(kp);
    GAS unsigned char* ws = (GAS unsigned char*)A.ws; OPQ(ws); OPQ(l);
    const int tid = opq_tid(), lane = tid & 63, wave = tid >> 6, gw = blockIdx.x * 8 + wave, NGW = G * 8;
    const bool more = (l + 1 < DEPTH);
    LAS f32x4* wg = (LAS f32x4*)lds;
    if (more) { load_gate_w(A.w_in + (size_t)(l + 1) * D * DIN, wg); }
    __syncthreads();
    bf16* XB = (bf16*)(ws + WS_XB); float* GT = (float*)(ws + WS_GATES);
    f32x4 gv[8], bv[8];
#pragma unroll
    for (int i = 0; i < 8; ++i) { gv[i] = *((const f32x4*)(A.ln_g + (size_t)l * D) + lane + 64 * i); bv[i] = *((const f32x4*)(A.ln_b + (size_t)l * D) + lane + 64 * i); }
    for (int m = gw; m < M; m += NGW) {
        f32x4* xr = (f32x4*)(A.out + (size_t)m * D) + lane;
        f32x4 v[8]; float s = 0.f;
#pragma unroll
        for (int i = 0; i < 8; ++i) { v[i] = xr[64 * i]; s += (v[i][0] + v[i][1]) + (v[i][2] + v[i][3]); }
        const float mean = wave_sum(s) * (1.f / D); float q = 0.f;
#pragma unroll
        for (int i = 0; i < 8; ++i) { v[i] = v[i] - mean; q += (v[i][0] * v[i][0] + v[i][1] * v[i][1]) + (v[i][2] * v[i][2] + v[i][3] * v[i][3]); }
        const float rstd = frsq(wave_sum(q) * (1.f / D) + LN_EPS);
#pragma unroll
        for (int i = 0; i < 8; ++i) { v[i] = v[i] * rstd * gv[i] + bv[i]; xr[64 * i] = v[i]; }
        if (more) {
            u32x2* o = (u32x2*)(XB + (size_t)m * D) + lane;
#pragma unroll
            for (int i = 0; i < 8; ++i) o[64 * i] = (u32x2){pk2(v[i][0], v[i][1]), pk2(v[i][2], v[i][3])};
            gate_dots(v, wg, GT + (size_t)m * 8, lane);
        }
    }
    __syncthreads();
}

constexpr size_t WS_BAR = 512 * 1024;
constexpr int LDS_MISC = LDS_BYTES - 64;
#define XB_TMO      128
#define XB_XCNT(j)  (256  + 64 * (j))
#define XB_XSUB(j)  (1280 + 64 * (j))
#define XB_XGEN(j)  (2304 + 64 * (j))
#define XB_TOP      3328
#define XB_TOPGEN   3392
#define XCD_BAR_WORDS 3456
#define XB_SPIN_CAP (1u << 18)

__device__ __forceinline__ unsigned xb_ld(unsigned* p)              { return __hip_atomic_load(p, __ATOMIC_RELAXED, __HIP_MEMORY_SCOPE_AGENT); }
__device__ __forceinline__ unsigned xb_add(unsigned* p, unsigned v) { return __hip_atomic_fetch_add(p, v, __ATOMIC_RELAXED, __HIP_MEMORY_SCOPE_AGENT); }
__device__ __forceinline__ unsigned xb_xcc_id() { return (unsigned)__builtin_amdgcn_s_getreg((3 << 11) | 20) & 0xFu; }
#define XB_SPIN(cond, bar) do { unsigned _sp = 0; while (cond) { __builtin_amdgcn_s_sleep(1); \
    if ((++_sp & 255u) == 0u) { if (xb_ld(&(bar)[XB_TMO])) break; if (_sp > XB_SPIN_CAP) { atomicAdd(&(bar)[XB_TMO], 1u); break; } } } } while (0)

struct XcdBarrier {
    unsigned* bar; unsigned x;
    volatile LAS unsigned* st;
};

__device__ __forceinline__ XcdBarrier xcd_barrier_post(unsigned* bar, volatile LAS unsigned* st) {
    XcdBarrier b; b.bar = bar; b.x = xb_xcc_id(); b.st = st;
    if (threadIdx.x == 0) (void)xb_add(&bar[XB_XCNT(b.x)], 1u);
    return b;
}
__device__ __forceinline__ void xcd_barrier_complete(unsigned* bar, unsigned x, unsigned& nloc, unsigned& nx) {
    const unsigned G = gridDim.x * gridDim.y * gridDim.z;
    unsigned sum, cnt, mine, sp = 0u;
    for (;;) {
        sum = 0u; cnt = 0u; mine = 0u;
#pragma unroll
        for (unsigned j = 0; j < 16; ++j) { const unsigned c = xb_ld(&bar[XB_XCNT(j)]); sum += c; cnt += (c > 0u) ? 1u : 0u; mine = (j == x) ? c : mine; }
        if (sum == G) break;
        __builtin_amdgcn_s_sleep(1);
        if ((++sp & 255u) == 0u) { if (xb_ld(&bar[XB_TMO])) break; if (sp > XB_SPIN_CAP) { atomicAdd(&bar[XB_TMO], 1u); break; } }
    }
    nloc = mine > 0u ? mine : 1u; nx = cnt > 0u ? cnt : 1u;
}

__device__ __forceinline__ void xcd_barrier(const XcdBarrier& b) {
    asm volatile("s_waitcnt vmcnt(0)" ::: "memory");
    __syncthreads();
    if (threadIdx.x == 0) {
        unsigned* bar = b.bar;
        __builtin_amdgcn_s_waitcnt(0);
        unsigned nloc = b.st[0], nx = b.st[1];
        if (nloc == 0u) { xcd_barrier_complete(bar, b.x, nloc, nx); b.st[0] = nloc; b.st[1] = nx; }
        const unsigned old = xb_add(&bar[XB_XSUB(b.x)], 1u);
        const unsigned gen = old / nloc;
        if (old + 1u == (gen + 1u) * nloc) {
            __builtin_amdgcn_fence(__ATOMIC_RELEASE, "agent");
            asm volatile("s_waitcnt vmcnt(0)" ::: "memory");
            const unsigned og = xb_add(&bar[XB_TOP], 1u);
            const unsigned tg = og / nx;
            if (og + 1u == (tg + 1u) * nx) xb_add(&bar[XB_TOPGEN], 1u);
            else XB_SPIN(xb_ld(&bar[XB_TOPGEN]) == tg, bar);
            __builtin_amdgcn_fence(__ATOMIC_ACQUIRE, "agent");
            xb_add(&bar[XB_XGEN(b.x)], 1u);
            asm volatile("s_waitcnt vmcnt(0)" ::: "memory");
        } else {
            XB_SPIN(xb_ld(&bar[XB_XGEN(b.x)]) == gen, bar);
            __builtin_amdgcn_fence(__ATOMIC_ACQUIRE, "agent");
            asm volatile("s_waitcnt vmcnt(0)" ::: "memory");
        }
    }
    __syncthreads();
}


__global__ void __launch_bounds__(512, 2) fwd_megakernel(Args A_unused) {
    const KArgs kp = (KArgs)__builtin_amdgcn_kernarg_segment_ptr();
    extern __shared__ __attribute__((aligned(16))) unsigned char lds_raw[];
    LAS unsigned char* lds = (LAS unsigned char*)lds_raw;
    cg::grid_group grid = cg::this_grid();
    const int G = gridDim.x, bid = blockIdx.x;
    if (threadIdx.x < 16) ((LAS unsigned*)(lds + LDS_MISC))[threadIdx.x] = 0u;
    __syncthreads();
    XcdBarrier xbar;
    { const Args A0 = load_args(kp); xbar = xcd_barrier_post((unsigned*)(A0.ws + WS_BAR), (volatile LAS unsigned*)(lds + LDS_MISC)); }
#define GRID_SYNC() xcd_barrier(xbar)
#ifndef NO_P0
    p0_prologue(kp, lds, G);
#endif
#ifdef PROBE_P0
    GRID_SYNC(); p0_prologue(kp, lds, G);
#endif
    grid.sync();
#pragma unroll
    for (int l = 0; l < DEPTH; ++l) {
        {
            const Args A = load_args(kp);
            pg8::Gemm g{(const pg8::bf16_t*)(A.ws + WS_XB), (const pg8::bf16_t*)(A.ws + WS_WIN + l * WIN_BYTES), M, NZ, D};
            pg8::StaticOrder S; S.init(M, NZ, G, bid);
            pg8::EpiBf16<0> E{(pg8::bf16_t*)(A.ws + WS_Z), NZ, nullptr, 0, 0, 1.f};
#ifndef NO_G1
            pg8::gemm_phase<pg8::EpiBf16<0>, pg8::StaticOrder, true, true>(lds, g, S, E);
#endif
#ifdef PROBE_G1
            GRID_SYNC(); pg8::gemm_phase<pg8::EpiBf16<0>, pg8::StaticOrder, true, true>(lds, g, S, E);
#endif
        }
        GRID_SYNC();
#ifdef PROBE_P2
        {   attn_phase(kp, lds, G, true);
            constexpr int N_SGU = 256, N_CONV = 1024;
            for (int it = bid; it < N_SGU + N_CONV; it += G) {
                if (it < N_SGU) sgu_unit(kp, l, it, lds, true);
                if (it >= N_SGU) conv_unit(kp, l, it - N_SGU);
            }
        }
        GRID_SYNC();
#endif
#ifdef PROBE_SGU
        for (int it = bid; it < 256; it += G) sgu_unit(kp, l, it, lds, true);
        GRID_SYNC();
#endif
#ifdef PROBE_CONV
        for (int it = bid; it < 1024; it += G) conv_unit(kp, l, it);
        GRID_SYNC();
#endif
#ifdef PROBE_ATT
        attn_phase(kp, lds, G, true);
        GRID_SYNC();
#endif
        {
#ifndef NO_ATT
            attn_phase(kp, lds, G);
#endif
            constexpr int N_SGU = 256, N_CONV = 1024;
            for (int it = bid; it < N_SGU + N_CONV; it += G) {
#ifndef NO_SGU
                if (it < N_SGU) sgu_unit(kp, l, it, lds);
#endif
#ifndef NO_CONV
                if (it >= N_SGU) conv_unit(kp, l, it - N_SGU);
#endif
            }
        }
        GRID_SYNC();
#ifdef PROBE_ML
        for (int it = bid; it < 256; it += G) mlstm_unit(kp, l, it, lds, true);
        GRID_SYNC();
#endif
#ifndef NO_ML
        for (int it = bid; it < 256; it += G) mlstm_unit(kp, l, it, lds);
#endif
        GRID_SYNC();
#ifndef NO_FIN
        finish_phase(kp, l, G);
#endif
#ifdef PROBE_FIN
        GRID_SYNC(); finish_phase(kp, l, G);
#endif
        GRID_SYNC();
        {
            const Args A = load_args(kp);
            pg8::Gemm g{(const pg8::bf16_t*)(A.ws + WS_XB), (const pg8::bf16_t*)(A.ws + WS_WOUT + l * WOUT_BYTES), M, D, D};
            pg8::StaticOrder S; S.init(M, D, G, bid);
            pg8::EpiResF32 E{l == 0 ? A.x : (const float*)A.out, A.out, D, 1.41421356237f};
#ifndef NO_G2
            pg8::gemm_phase<pg8::EpiResF32, pg8::StaticOrder, true, true>(lds, g, S, E);
#endif
#ifdef PROBE_G2
            if (l == 0) { GRID_SYNC(); pg8::gemm_phase<pg8::EpiResF32, pg8::StaticOrder, true, true>(lds, g, S, E); }
#endif
        }
        GRID_SYNC();
#ifdef PROBE_SYNC
        for (int i = 0; i < 10; ++i) GRID_SYNC();
#endif
#ifndef NO_LN
        ln_phase(kp, l, G, lds);
#endif
        if (l + 1 < DEPTH) GRID_SYNC();
    }
}

extern "C" void kernel_launch(void* const* d_in, const int* in_sizes, int n_in, void* d_out, int out_size, void* d_ws, size_t ws_size, hipStream_t stream) {
    static int grid = 0;
    if (grid == 0) {
        if (n_in != 15 || out_size != M * D || ws_size < WS_END) { fprintf(stderr, "kernel_launch: unexpected shapes (n_in %d out %d ws %zu need %zu)\n", n_in, out_size, ws_size, (size_t)WS_END); grid = -1; return; }
        int dev = 0, cus = 0, per_cu = 0;
        (void)hipGetDevice(&dev);
        (void)hipDeviceGetAttribute(&cus, hipDeviceAttributeMultiprocessorCount, dev);
        (void)hipFuncSetAttribute((const void*)fwd_megakernel, hipFuncAttributeMaxDynamicSharedMemorySize, LDS_BYTES);
        (void)hipOccupancyMaxActiveBlocksPerMultiprocessor(&per_cu, (const void*)fwd_megakernel, 512, LDS_BYTES);
        if (per_cu < 1) per_cu = 1;
        grid = cus * per_cu;
    }
    if (grid < 0) return;
    Args a{};
    a.x = (const float*)d_in[0]; a.pos = (const int*)d_in[1]; a.w_in = (const float*)d_in[2]; a.sgu_ln_g = (const float*)d_in[3]; a.sgu_ln_b = (const float*)d_in[4];
    a.w_spatial = (const float*)d_in[5]; a.b_spatial = (const float*)d_in[6]; a.conv_w = (const float*)d_in[7]; a.conv_b = (const float*)d_in[8];
    a.b_igate = (const float*)d_in[9]; a.b_fgate = (const float*)d_in[10]; a.head_norm_g = (const float*)d_in[11]; a.w_out = (const float*)d_in[12];
    a.ln_g = (const float*)d_in[13]; a.ln_b = (const float*)d_in[14]; a.out = (float*)d_out; a.ws = (unsigned char*)d_ws;
    (void)hipMemsetAsync((unsigned char*)d_ws + WS_BAR, 0, XCD_BAR_WORDS * 4, stream);
    void* args[] = {&a};
    hipError_t e = hipLaunchCooperativeKernel((void*)fwd_megakernel, dim3(grid), dim3(512), args, LDS_BYTES, stream);
    if (e != hipSuccess) fprintf(stderr, "cooperative launch failed: %s (grid %d)\n", hipGetErrorString(e), grid);
}
```

```cpp
#include <hip/hip_runtime.h>
#include <hip/hip_cooperative_groups.h>
#include <cstdio>
#include <cstdint>
namespace cg = cooperative_groups;
namespace pg8 {
#define PG8_LAS __attribute__((address_space(3)))
typedef unsigned short bf16_t;
typedef short bf16x8 __attribute__((ext_vector_type(8)));
typedef float f32x4 __attribute__((ext_vector_type(4)));
typedef unsigned u32x4 __attribute__((ext_vector_type(4)));
constexpr int BM = 256, BK = 64, HALF = 128, HTB = HALF * BK * 2  , STAGE_BYTES = 8 * HTB, NXCD = 8, WGM = 8;

__host__ __device__ __forceinline__ int lds_byte(int r, int c) { const int st = (r >> 4) * 2 + (c >> 5), rr = r & 15, cc = c & 31, ob = rr * 64 + cc * 2; return st * 1024 + (ob ^ (((ob >> 9) & 1) << 5)); }
__host__ __device__ __forceinline__ void stage_rc(int b, int& R, int& C) { const int st = b / 1024, sb = b % 1024, swz = sb ^ (((sb >> 9) & 1) << 5); R = (st >> 1) * 16 + swz / 64; C = (st & 1) * 32 + (swz % 64) / 2; }
__host__ __device__ __forceinline__ int perm32(int rho) { const int n = rho >> 4, i = rho & 15; return 8 * (i >> 2) + 4 * n + (i & 3); }

struct Unit { int pm, pn; };
struct Gemm { const bf16_t* A; const bf16_t* Bt; int M, N, K; };

struct StaticOrder {
    int nM, nN, nwg, G, c;
    __host__ __device__ void init(int M, int N, int G_, int c_) { nM = M / BM; nN = N / BM; nwg = nM * nN; G = G_; c = c_; }
    __host__ __device__ bool next(int i, Unit& u) const {
        const long L = (long)i * G + c; if (L >= nwg) return false;
        int wgid = (int)L; { const int q = nwg / NXCD, r = nwg % NXCD, xcd = wgid % NXCD, off = wgid / NXCD; wgid = (xcd < r ? xcd * (q + 1) : r * (q + 1) + (xcd - r) * q) + off; }
        const int nig = WGM * nN, gid = wgid / nig, fm = gid * WGM, gsz = (nM - fm) < WGM ? (nM - fm) : WGM;
        u.pm = fm + ((wgid % nig) % gsz); u.pn = (wgid % nig) / gsz; return true;
    }
    __device__ __forceinline__ void a_ready(const Unit&) const {}
    __device__ __forceinline__ void done(const Unit&) const {}
};

__device__ __forceinline__ unsigned cvt_pk_bf16(float lo, float hi) { unsigned r; asm volatile("v_cvt_pk_bf16_f32 %0, %1, %2" : "=v"(r) : "v"(lo), "v"(hi)); return r; }
typedef float f32x2 __attribute__((ext_vector_type(2)));
__device__ __forceinline__ f32x2 gelu_pk(f32x2 v) {
    const f32x2 av = __builtin_elementwise_abs(v), d = av * 0.2316418882f + 1.0f;
    f32x2 t; t.x = __builtin_amdgcn_rcpf(d.x); t.y = __builtin_amdgcn_rcpf(d.y);
    f32x2 q = t * 0.5307027145f + (-0.7265760135f); q = q * t + 0.7107068705f; q = q * t + (-0.142248368f); q = q * t + 0.127414796f; q = q * t;
    const f32x2 s = (v * v) * (-0.72134752044f);
    f32x2 e; e.x = __builtin_amdgcn_exp2f(s.x); e.y = __builtin_amdgcn_exp2f(s.y);
    const f32x2 m = v * (q * e), r = v - m;
    f32x2 o; o.x = v.x < 0.f ? m.x : r.x; o.y = v.y < 0.f ? m.y : r.y; return o;
}

template <int ACT  > struct EpiBf16 {
    static constexpr bool PERM = true, AFTER_DRAIN = false; static_assert(ACT == 0 || ACT == 1, "EpiBf16: ACT is 0 (none) or 1 (gelu_pk)");
    bf16_t* O; int ldc; const float* bias; int split_cols; size_t split_stride; float scale0;
    __device__ __forceinline__ void operator()(const f32x4 (&acc)[2][2][4][2], const Unit& u, int wr, int wc, int fr, int fq) const {
        const int row0 = u.pm * BM + wr * 64 + fr; int colt = u.pn * BM; bf16_t* base = O;
        float sc = 1.f; if (split_cols) { const int t = colt / split_cols; base += (size_t)t * split_stride; colt -= t * split_cols; if (t == 0) sc = scale0; }
        const int col0 = colt + wc * 32 + 8 * fq, bcol0 = u.pn * BM + wc * 32 + 8 * fq;
        f32x4 bv[2][2];
#pragma unroll
        for (int bj = 0; bj < 2; ++bj)
#pragma unroll
            for (int n = 0; n < 2; ++n) bv[bj][n] = bias ? *(const f32x4*)(bias + bcol0 + bj * HALF + 4 * n) : (f32x4){0.f, 0.f, 0.f, 0.f};
#pragma unroll
        for (int ai = 0; ai < 2; ++ai)
#pragma unroll
            for (int m = 0; m < 4; ++m) { bf16_t* rowp = base + (size_t)(row0 + ai * HALF + m * 16) * ldc + col0;
#pragma unroll
                for (int bj = 0; bj < 2; ++bj) { f32x4 v0 = acc[ai][bj][m][0] + bv[bj][0], v1 = acc[ai][bj][m][1] + bv[bj][1];
                    if (ACT == 1) { f32x2 a = gelu_pk((f32x2){v0[0], v0[1]}), b = gelu_pk((f32x2){v0[2], v0[3]}), c = gelu_pk((f32x2){v1[0], v1[1]}), d = gelu_pk((f32x2){v1[2], v1[3]});
                        v0 = (f32x4){a.x, a.y, b.x, b.y}; v1 = (f32x4){c.x, c.y, d.x, d.y}; }
                    v0 = v0 * sc; v1 = v1 * sc; u32x4 w; w.x = cvt_pk_bf16(v0[0], v0[1]); w.y = cvt_pk_bf16(v0[2], v0[3]); w.z = cvt_pk_bf16(v1[0], v1[1]); w.w = cvt_pk_bf16(v1[2], v1[3]);
                    *(u32x4*)(rowp + bj * HALF) = w; } }
    }
};
struct EpiResF32 {
    static constexpr bool PERM = true, AFTER_DRAIN = false;
    const float* R; float* O; int ldc; float alpha;
    __device__ __forceinline__ void operator()(const f32x4 (&acc)[2][2][4][2], const Unit& u, int wr, int wc, int fr, int fq) const {
        const int row0 = u.pm * BM + wr * 64 + fr, col0 = u.pn * BM + wc * 32 + 8 * fq;
#pragma unroll
        for (int ai = 0; ai < 2; ++ai)
#pragma unroll
            for (int m = 0; m < 4; ++m) {
                const size_t ro = (size_t)(row0 + ai * HALF + m * 16) * ldc + col0;
#pragma unroll
                for (int bj = 0; bj < 2; ++bj) {
                    const f32x4 r0 = *(const f32x4*)(R + ro + bj * HALF), r1 = *(const f32x4*)(R + ro + bj * HALF + 4);
                    *(f32x4*)(O + ro + bj * HALF) = r0 * alpha + acc[ai][bj][m][0];
                    *(f32x4*)(O + ro + bj * HALF + 4) = r1 * alpha + acc[ai][bj][m][1];
                }
            }
    }
};
template <class Epi, class Sched, bool ALIGN_EPI = false, bool SP2 = false>
__device__ __forceinline__ void gemm_phase(PG8_LAS unsigned char* lds, const Gemm g, const Sched& S, const Epi& E) {
    int tid_l = threadIdx.x; asm volatile("" : "+v"(tid_l));
    const int tid = tid_l, wid = __builtin_amdgcn_readfirstlane(tid >> 6), lane = tid & 63, wr = wid >> 2, wc = wid & 3, fr = lane & 15, fq = lane >> 4;
    const int K = g.K, nt = K / BK;
    unsigned voffA[2], voffB[2];
#pragma unroll
    for (int i = 0; i < 2; ++i) { int R, C; stage_rc(tid * 16 + i * 8192, R, C); const int Rb = Epi::PERM ? ((R & ~31) + perm32(R & 31)) : R;
        voffA[i] = (unsigned)(R * K + C) * 2u; voffB[i] = (unsigned)(Rb * K + C) * 2u; }
    const size_t kstep = (size_t)(BK * 2);
    const size_t hstep = (size_t)HALF * K * 2;
    const size_t tstep = 2 * hstep;
    const unsigned ldsw = (unsigned)wid * 1024u;
    const int aoff = lds_byte(wr * 64 + fr, fq * 8), boff = lds_byte(wc * 32 + fr, fq * 8);
#define PG8_SA(b, h) (((b) * 2 + (h)) * HTB)
#define PG8_SB(b, h) ((4 + (b) * 2 + (h)) * HTB)
#define PG8_STAGE(bufoff, gbase, voff) do { _Pragma("unroll") for (int _i = 0; _i < 2; ++_i) \
        __builtin_amdgcn_global_load_lds((const unsigned*)((const char*)(gbase) + (voff)[_i]), (PG8_LAS unsigned*)(lds + (bufoff) + ldsw + _i * 8192), 16, 0, 0); } while (0)
#define PG8_LDA(dst, b, h) do { _Pragma("unroll") for (int m = 0; m < 4; ++m) _Pragma("unroll") for (int k = 0; k < 2; ++k) dst[m][k] = *(const PG8_LAS bf16x8*)(lds + PG8_SA(b, h) + aoff + m * 2048 + k * 1024); } while (0)
#define PG8_LDB(dst, b, h) do { _Pragma("unroll") for (int n = 0; n < 2; ++n) _Pragma("unroll") for (int k = 0; k < 2; ++k) dst[n][k] = *(const PG8_LAS bf16x8*)(lds + PG8_SB(b, h) + boff + n * 2048 + k * 1024); } while (0)
#define PG8_MMA(ai, bj, At, Bt) do { __builtin_amdgcn_s_setprio(1); _Pragma("unroll") for (int m = 0; m < 4; ++m) _Pragma("unroll") for (int n = 0; n < 2; ++n) _Pragma("unroll") for (int k = 0; k < 2; ++k) \
        acc[ai][bj][m][n] = __builtin_amdgcn_mfma_f32_16x16x32_bf16(Bt[n][k], At[m][k], acc[ai][bj][m][n], 0, 0, 0); __builtin_amdgcn_s_setprio(0); } while (0)
#define PG8_WAIT_V(n) asm volatile("s_waitcnt vmcnt(" #n ")" ::: "memory")
#define PG8_WAIT_L(n) asm volatile("s_waitcnt lgkmcnt(" #n ")" ::: "memory")
#define PG8_BAR __builtin_amdgcn_s_barrier()
#define PG8_SCHED __builtin_amdgcn_sched_barrier(0)
    Unit cur, nxt; int ui = 0;
    if (!S.next(0, cur)) return;
    f32x4 acc[2][2][4][2];
#pragma unroll
    for (int a = 0; a < 2; ++a)
#pragma unroll
        for (int b = 0; b < 2; ++b)
#pragma unroll
            for (int m = 0; m < 4; ++m)
#pragma unroll
                for (int n = 0; n < 2; ++n) acc[a][b][m][n] = (f32x4){0.f, 0.f, 0.f, 0.f};
    bf16x8 At[4][2], B0[2][2], B1[2][2];
    const char* cA = (const char*)g.A + (size_t)cur.pm * tstep; const char* cB = (const char*)g.Bt + (size_t)cur.pn * tstep;
    S.a_ready(cur);
    if constexpr (SP2) {
        PG8_STAGE(PG8_SB(0, 0), cB, voffB); PG8_STAGE(PG8_SB(0, 1), cB + hstep, voffB); PG8_STAGE(PG8_SA(0, 0), cA, voffA); PG8_STAGE(PG8_SA(0, 1), cA + hstep, voffA);
        if (wr == 1) PG8_BAR;
        PG8_WAIT_V(2); PG8_BAR;
        PG8_STAGE(PG8_SB(1, 0), cB + kstep, voffB); PG8_STAGE(PG8_SA(1, 0), cA + kstep, voffA); PG8_STAGE(PG8_SB(1, 1), cB + hstep + kstep, voffB);
        PG8_WAIT_V(6); PG8_BAR;
    } else {
        PG8_STAGE(PG8_SB(0, 0), cB, voffB); PG8_STAGE(PG8_SA(0, 0), cA, voffA); PG8_STAGE(PG8_SB(0, 1), cB + hstep, voffB); PG8_STAGE(PG8_SA(0, 1), cA + hstep, voffA);
        if (wr == 1) PG8_BAR;
        PG8_WAIT_V(4); PG8_BAR;
        PG8_STAGE(PG8_SB(1, 0), cB + kstep, voffB); PG8_STAGE(PG8_SA(1, 0), cA + kstep, voffA); PG8_STAGE(PG8_SB(1, 1), cB + hstep + kstep, voffB);
        PG8_WAIT_V(6); PG8_BAR;
    }
    for (;;) {
        const bool has_next = S.next(ui + 1, nxt);
        const char* nA = has_next ? (const char*)g.A + (size_t)nxt.pm * tstep : cA; const char* nB = has_next ? (const char*)g.Bt + (size_t)nxt.pn * tstep : cB;
        for (int t = 0; t < nt; t += 2) {
            const bool last = (t == nt - 2);
            const char* a1 = cA + (size_t)(t + 1) * kstep;
            const char* a2 = last ? nA : cA + (size_t)(t + 2) * kstep; const char* b2 = last ? nB : cB + (size_t)(t + 2) * kstep;
            const char* a3 = a2 + kstep; const char* b3 = b2 + kstep;
            if (last && has_next) S.a_ready(nxt);
            if constexpr (SP2) {
            PG8_LDB(B0, 0, 0); PG8_LDB(B1, 0, 1); PG8_SCHED; PG8_LDA(At, 0, 0); PG8_STAGE(PG8_SA(1, 1), a1 + hstep, voffA);
            PG8_WAIT_V(8); PG8_WAIT_L(0); PG8_BAR; PG8_MMA(0, 0, At, B0); PG8_MMA(0, 1, At, B1); PG8_BAR; PG8_SCHED;
            PG8_LDA(At, 0, 1); PG8_STAGE(PG8_SB(0, 0), b2, voffB); PG8_STAGE(PG8_SB(0, 1), b2 + hstep, voffB); PG8_STAGE(PG8_SA(0, 0), a2, voffA);
            PG8_WAIT_V(8); PG8_WAIT_L(0); PG8_BAR; PG8_MMA(1, 0, At, B0); PG8_MMA(1, 1, At, B1); PG8_BAR; PG8_SCHED;
            PG8_LDB(B0, 1, 0); PG8_LDB(B1, 1, 1); PG8_SCHED; PG8_LDA(At, 1, 0); PG8_STAGE(PG8_SA(0, 1), a2 + hstep, voffA);
            PG8_WAIT_V(8); PG8_WAIT_L(0); PG8_BAR; PG8_MMA(0, 0, At, B0); PG8_MMA(0, 1, At, B1); PG8_BAR; PG8_SCHED;
            PG8_LDA(At, 1, 1); PG8_STAGE(PG8_SB(1, 0), b3, voffB); PG8_STAGE(PG8_SB(1, 1), b3 + hstep, voffB); PG8_STAGE(PG8_SA(1, 0), a3, voffA);
            PG8_WAIT_V(8); PG8_WAIT_L(0); PG8_BAR; PG8_MMA(1, 0, At, B0); PG8_MMA(1, 1, At, B1); PG8_BAR; PG8_SCHED;
            } else {
            PG8_LDB(B0, 0, 0); PG8_SCHED; PG8_LDA(At, 0, 0); PG8_STAGE(PG8_SA(1, 1), a1 + hstep, voffA);
            PG8_WAIT_L(8); PG8_BAR; PG8_WAIT_L(0); PG8_MMA(0, 0, At, B0); PG8_BAR; PG8_SCHED;
            PG8_LDB(B1, 0, 1); PG8_STAGE(PG8_SB(0, 0), b2, voffB);
            PG8_BAR; PG8_WAIT_L(0); PG8_MMA(0, 1, At, B1); PG8_BAR;
            PG8_LDA(At, 0, 1); PG8_STAGE(PG8_SA(0, 0), a2, voffA);
            PG8_BAR; PG8_WAIT_L(0); PG8_MMA(1, 0, At, B0); PG8_BAR; PG8_SCHED;
            PG8_STAGE(PG8_SB(0, 1), b2 + hstep, voffB);
            PG8_WAIT_V(6); PG8_BAR; PG8_MMA(1, 1, At, B1); PG8_BAR;
            PG8_LDB(B0, 1, 0); PG8_SCHED; PG8_LDA(At, 1, 0); PG8_STAGE(PG8_SA(0, 1), a2 + hstep, voffA);
            PG8_WAIT_L(8); PG8_BAR; PG8_WAIT_L(0); PG8_MMA(0, 0, At, B0); PG8_BAR; PG8_SCHED;
            PG8_LDB(B1, 1, 1); PG8_STAGE(PG8_SB(1, 0), b3, voffB);
            PG8_BAR; PG8_WAIT_L(0); PG8_MMA(0, 1, At, B1); PG8_BAR;
            PG8_LDA(At, 1, 1); PG8_STAGE(PG8_SA(1, 0), a3, voffA);
            PG8_BAR; PG8_WAIT_L(0); PG8_MMA(1, 0, At, B0); PG8_BAR; PG8_SCHED;
            PG8_STAGE(PG8_SB(1, 1), b3 + hstep, voffB);
            PG8_WAIT_V(6); PG8_BAR; PG8_MMA(1, 1, At, B1); PG8_BAR;
            }
        }
        if constexpr (ALIGN_EPI) { if (wr == 0) PG8_BAR; }
        if constexpr (!Epi::AFTER_DRAIN) { E(acc, cur, wr, wc, fr, fq); S.done(cur); }
        if (!has_next) break;
#pragma unroll
        for (int a = 0; a < 2; ++a)
#pragma unroll
            for (int b = 0; b < 2; ++b)
#pragma unroll
                for (int m = 0; m < 4; ++m)
#pragma unroll
                    for (int n = 0; n < 2; ++n) acc[a][b][m][n] = (f32x4){0.f, 0.f, 0.f, 0.f};
        cur = nxt; cA = nA; cB = nB; ++ui;
        if constexpr (ALIGN_EPI) { if (wr == 1) PG8_BAR; }
    }
    PG8_WAIT_V(0);
    if constexpr (!ALIGN_EPI) { if (wr == 0) PG8_BAR; }
    PG8_BAR;
    if constexpr (Epi::AFTER_DRAIN) { E.fused(acc, cur, wr, wc, fr, fq, lds, wid, lane); S.done(cur); }
#undef PG8_SA
#undef PG8_SB
#undef PG8_STAGE
#undef PG8_LDA
#undef PG8_LDB
#undef PG8_MMA
#undef PG8_WAIT_V
#undef PG8_WAIT_L
#undef PG8_BAR
#undef PG8_SCHED
}
}

constexpr int NB = 8, SEQ = 4096, M = NB * SEQ, D = 2048, DIN = 11784, NZ = 11776, DEPTH = 2;
constexpr int Z_AQ = 0, Z_AK = 1536, Z_AV = 3072, Z_AG = 4608, Z_SU = 5120, Z_SV = 5632, Z_SG = 6144, Z_MQ = 6656, Z_MK = 7680, Z_MV = 8704, Z_MO = 9728, Z_MG = 10752;
constexpr size_t MiB = 1u << 20;
constexpr size_t WIN_BYTES = (size_t)NZ * D * 2, WOUT_BYTES = (size_t)D * D * 2;
constexpr size_t WS_WIN = 1 * MiB, WS_WOUT = WS_WIN + 2 * WIN_BYTES, WS_GATES = WS_WOUT + 2 * WOUT_BYTES, WS_LSE = WS_GATES + (size_t)M * 8 * 4;
constexpr size_t WS_XB = 114 * MiB, WS_Z = WS_XB + (size_t)M * D * 2, WS_END = WS_Z + (size_t)M * NZ * 2;
static_assert(WS_LSE + (size_t)M * 24 * 4 <= WS_XB, "ws map");
constexpr int LDS_BYTES = 159744;
constexpr float LN_EPS = 1e-5f;

typedef unsigned short bf16;
typedef short bf16x8 __attribute__((ext_vector_type(8)));
typedef float f32x4 __attribute__((ext_vector_type(4)));
typedef unsigned u32x4 __attribute__((ext_vector_type(4)));
typedef unsigned u32x2 __attribute__((ext_vector_type(2)));
typedef short s16x4 __attribute__((ext_vector_type(4)));
#define LAS __attribute__((address_space(3)))

struct Args {
    const float* x; const int* pos; const float* w_in; const float* sgu_ln_g; const float* sgu_ln_b; const float* w_spatial; const float* b_spatial;
    const float* conv_w; const float* conv_b; const float* b_igate; const float* b_fgate; const float* head_norm_g; const float* w_out; const float* ln_g; const float* ln_b;
    float* out; unsigned char* ws;
};

__device__ __forceinline__ float bflo(unsigned w) { return __builtin_bit_cast(float, w << 16); }
__device__ __forceinline__ float bfhi(unsigned w) { return __builtin_bit_cast(float, w & 0xffff0000u); }
__device__ __forceinline__ float bf1(bf16 u) { return __builtin_bit_cast(float, (unsigned)u << 16); }
typedef float f32x2_t __attribute__((ext_vector_type(2)));
typedef __bf16 bf16x2_t __attribute__((ext_vector_type(2)));
__device__ __forceinline__ unsigned pk2(float lo, float hi) { const f32x2_t v = {lo, hi}; return __builtin_bit_cast(unsigned, __builtin_convertvector(v, bf16x2_t)); }
__device__ __forceinline__ unsigned f2bf(float f) { return pk2(f, 0.f) & 0xffffu; }
#define UNPACK8(v, f) do { f[0] = bflo(v.x); f[1] = bfhi(v.x); f[2] = bflo(v.y); f[3] = bfhi(v.y); f[4] = bflo(v.z); f[5] = bfhi(v.z); f[6] = bflo(v.w); f[7] = bfhi(v.w); } while (0)
#define PACK8(f) ((u32x4){pk2(f[0], f[1]), pk2(f[2], f[3]), pk2(f[4], f[5]), pk2(f[6], f[7])})
__device__ __forceinline__ float fexp(float x) { return __builtin_amdgcn_exp2f(x * 1.4426950408889634f); }
__device__ __forceinline__ float flog(float x) { return __builtin_amdgcn_logf(x) * 0.6931471805599453f; }
__device__ __forceinline__ float frcp(float x) { return __builtin_amdgcn_rcpf(x); }
__device__ __forceinline__ float frsq(float x) { return __builtin_amdgcn_rsqf(x); }
__device__ __forceinline__ float silu_f(float y) { return y * frcp(1.f + fexp(-y)); }
__device__ __forceinline__ float sigmoid_f(float y) { return frcp(1.f + fexp(-y)); }
__device__ __forceinline__ float gelu_f(float v) {
    const float av = fabsf(v), t = __builtin_amdgcn_rcpf(av * 0.2316418882f + 1.0f);
    float q = t * 0.5307027145f + (-0.7265760135f); q = q * t + 0.7107068705f; q = q * t + (-0.142248368f); q = q * t + 0.127414796f; q = q * t;
    const float e = __builtin_amdgcn_exp2f((v * v) * (-0.72134752044f));
    const float m = v * (q * e);
    return v < 0.f ? m : v - m;
}
__device__ __forceinline__ f32x4 mfma16(bf16x8 a, bf16x8 b, f32x4 c) { return __builtin_amdgcn_mfma_f32_16x16x32_bf16(a, b, c, 0, 0, 0); }
__device__ __forceinline__ bf16x8 frag_kc(const LAS bf16* base, int ld, int r0, int k0, int lane) {
    return *(const LAS bf16x8*)(base + (r0 + (lane & 15)) * ld + k0 + 8 * (lane >> 4));
}
__device__ __forceinline__ s16x4 tr_rd(const LAS bf16* p) { return __builtin_bit_cast(s16x4, __builtin_amdgcn_ds_read_tr16_b64_v4i16((LAS s16x4*)p)); }
__device__ __forceinline__ bf16x8 frag_ks(const LAS bf16* base, int ld, int k0, int r0, int lane) {
    const int g = lane >> 4, q = (lane & 15) >> 2, p = lane & 3;
    const LAS bf16* a = base + (k0 + 8 * g + q) * ld + r0 + 4 * p;
    const s16x4 lo = tr_rd(a), hi = tr_rd(a + 4 * ld);
    return (bf16x8){lo[0], lo[1], lo[2], lo[3], hi[0], hi[1], hi[2], hi[3]};
}
__device__ __forceinline__ float wave_sum(float v) {
#pragma unroll
    for (int o = 1; o < 64; o <<= 1) v += __shfl_xor(v, o);
    return v;
}
__device__ __forceinline__ float sum16(float v) { v += __shfl_xor(v, 1); v += __shfl_xor(v, 2); v += __shfl_xor(v, 4); v += __shfl_xor(v, 8); return v; }
__device__ __forceinline__ float max16(float v) { v = fmaxf(v, __shfl_xor(v, 1)); v = fmaxf(v, __shfl_xor(v, 2)); v = fmaxf(v, __shfl_xor(v, 4)); v = fmaxf(v, __shfl_xor(v, 8)); return v; }
#define LDS_WAIT() asm volatile("s_waitcnt lgkmcnt(0)" ::: "memory")
#define OPQ(x) asm volatile("" : "+s"(x))
#define GAS __attribute__((address_space(1)))
template <class T> __device__ __forceinline__ T* as_global(T* p) { return (T*)(GAS T*)p; }
typedef const Args __attribute__((address_space(4)))* KArgs;
__device__ __forceinline__ Args load_args(KArgs p) {
#if defined(__HIP_DEVICE_COMPILE__)
    asm volatile("" : "+s"(p)); Args a = *p;
    a.x = as_global(a.x); a.pos = as_global(a.pos); a.w_in = as_global(a.w_in); a.sgu_ln_g = as_global(a.sgu_ln_g); a.sgu_ln_b = as_global(a.sgu_ln_b); a.w_spatial = as_global(a.w_spatial); a.b_spatial = as_global(a.b_spatial);
    a.conv_w = as_global(a.conv_w); a.conv_b = as_global(a.conv_b); a.b_igate = as_global(a.b_igate); a.b_fgate = as_global(a.b_fgate); a.head_norm_g = as_global(a.head_norm_g); a.w_out = as_global(a.w_out);
    a.ln_g = as_global(a.ln_g); a.ln_b = as_global(a.ln_b); a.out = as_global(a.out); a.ws = as_global(a.ws);
    return a;
#else
    return Args{};
#endif
}
__device__ __forceinline__ int opq_tid() { int t = threadIdx.x; asm volatile("" : "+v"(t)); return t; }

__device__ __forceinline__ void transpose_item(const float* W, int ldw, int K, bf16* WT, LAS float* scr, int item, int nblk, int lane) {
    const int kb = item / nblk, nb = item % nblk, k0 = 64 * kb, n0 = 32 * nb;
#pragma unroll 8
    for (int i = 0; i < 32; ++i) { const int kk = 2 * i + (lane >> 5); scr[kk * 33 + (lane & 31)] = W[(size_t)(k0 + kk) * ldw + n0 + (lane & 31)]; }
    LDS_WAIT();
    const int c = lane & 7;
#pragma unroll
    for (int j = 0; j < 4; ++j) { const int n = (lane >> 3) + 8 * j; const LAS float* s = scr + (8 * c) * 33 + n;
        u32x4 o; o.x = pk2(s[0 * 33], s[1 * 33]); o.y = pk2(s[2 * 33], s[3 * 33]); o.z = pk2(s[4 * 33], s[5 * 33]); o.w = pk2(s[6 * 33], s[7 * 33]);
        *(u32x4*)(WT + (size_t)(n0 + n) * K + k0 + 8 * c) = o; }
    LDS_WAIT();
}
__device__ __forceinline__ void load_gate_w(const float* w_in_l, LAS f32x4* wg) {
    for (int idx = opq_tid(); idx < 4096; idx += 512) { const int k = idx >> 1, hh = idx & 1, i = k >> 8, ln = (k & 255) >> 2, e = k & 3;
        wg[((i * 4 + e) * 2 + hh) * 64 + ln] = *(const f32x4*)(w_in_l + (size_t)k * DIN + NZ + 4 * hh); }
}
__device__ __forceinline__ void gate_dots(const f32x4 (&v)[8], const LAS f32x4* wg, float* gates, int lane) {
    f32x4 a0 = {0.f, 0.f, 0.f, 0.f}, a1 = {0.f, 0.f, 0.f, 0.f};
#pragma unroll
    for (int i = 0; i < 8; ++i)
#pragma unroll
        for (int e = 0; e < 4; ++e) { const f32x4 w0 = wg[((i * 4 + e) * 2 + 0) * 64 + lane], w1 = wg[((i * 4 + e) * 2 + 1) * 64 + lane]; a0 += w0 * v[i][e]; a1 += w1 * v[i][e];
            if (e == 3) __builtin_amdgcn_sched_barrier(0); }
#pragma unroll
    for (int e = 0; e < 4; ++e) { a0[e] = wave_sum(a0[e]); a1[e] = wave_sum(a1[e]); }
    if (lane == 0) { *(f32x4*)gates = a0; *(f32x4*)(gates + 4) = a1; }
}
__device__ __forceinline__ void p0_prologue(KArgs kp, LAS unsigned char* lds, int G) {
    const Args A = load_args(kp);
    GAS unsigned char* ws = (GAS unsigned char*)A.ws; OPQ(ws);
    const int tid = opq_tid(), lane = tid & 63, wave = tid >> 6;
    const int gw = blockIdx.x * 8 + wave, NGW = G * 8;
    LAS float* scr = (LAS float*)(lds + wave * 16384);
    constexpr int I_IN = (D / 64) * (NZ / 32), I_OUT = (D / 64) * (D / 32);
    for (int it = gw; it < 2 * (I_IN + I_OUT); it += NGW) {
        int r = it; const int l = r / (I_IN + I_OUT); r -= l * (I_IN + I_OUT);
        if (r < I_IN) transpose_item(A.w_in + (size_t)l * D * DIN, DIN, D, (bf16*)(ws + WS_WIN + l * WIN_BYTES), scr, r, NZ / 32, lane);
        else transpose_item(A.w_out + (size_t)l * D * D, D, D, (bf16*)(ws + WS_WOUT + l * WOUT_BYTES), scr, r - I_IN, D / 32, lane);
    }
    __syncthreads();
    LAS f32x4* wg = (LAS f32x4*)lds;
    load_gate_w(A.w_in, wg);
    __syncthreads();
    bf16* XB = (bf16*)(ws + WS_XB); float* GT = (float*)(ws + WS_GATES);
    for (int m = gw; m < M; m += NGW) {
        const f32x4* xr = (const f32x4*)(A.x + (size_t)m * D) + lane;
        f32x4 v[8];
#pragma unroll
        for (int i = 0; i < 8; ++i) v[i] = xr[64 * i];
        u32x2* o = (u32x2*)(XB + (size_t)m * D) + lane;
#pragma unroll
        for (int i = 0; i < 8; ++i) o[64 * i] = (u32x2){pk2(v[i][0], v[i][1]), pk2(v[i][2], v[i][3])};
        gate_dots(v, wg, GT + (size_t)m * 8, lane);
    }
    __syncthreads();
}

__device__ __forceinline__ void conv_unit(KArgs kp, int l, int u) {
    const Args A = load_args(kp);
    GAS unsigned char* ws = (GAS unsigned char*)A.ws; OPQ(ws); OPQ(l);
    const int tid = opq_tid(), cgp = tid & 255, half = tid >> 8, c0 = 8 * cgp, r0 = 32 * u + 16 * half;
    const bf16* Z = (const bf16*)(ws + WS_Z); bf16* Q = (bf16*)(ws + WS_XB);
    const float* cw = A.conv_w + (size_t)l * 4 * 2048 + c0; const float* cb = A.conv_b + (size_t)l * 2048 + c0;
    const bf16* zp = Z + (size_t)r0 * NZ + Z_MQ + c0;
    u32x4 rows[19];
    const bool hist = (r0 & (SEQ - 1)) != 0;
#pragma unroll
    for (int t = 0; t < 3; ++t) { rows[t] = (u32x4){0u, 0u, 0u, 0u}; if (hist) rows[t] = *(const u32x4*)(zp + (size_t)(t - 3) * NZ); }
#pragma unroll
    for (int t = 0; t < 16; ++t) rows[3 + t] = *(const u32x4*)(zp + (size_t)t * NZ);
    float w0[8], w1[8], w2[8], w3[8], bb[8], x3[8], x2[8], x1[8], cur[8], y[8];
#pragma unroll
    for (int e = 0; e < 8; ++e) { w0[e] = cw[e]; w1[e] = cw[2048 + e]; w2[e] = cw[4096 + e]; w3[e] = cw[6144 + e]; bb[e] = cb[e]; }
    UNPACK8(rows[0], x3); UNPACK8(rows[1], x2); UNPACK8(rows[2], x1);
    const float sc = (c0 >= 1024) ? 0.0625f : 1.f;
#pragma unroll
    for (int t = 0; t < 16; ++t) {
        UNPACK8(rows[3 + t], cur);
#pragma unroll
        for (int e = 0; e < 8; ++e) { const float sv = bb[e] + w0[e] * x3[e] + w1[e] * x2[e] + w2[e] * x1[e] + w3[e] * cur[e]; y[e] = silu_f(sv) * sc; x3[e] = x2[e]; x2[e] = x1[e]; x1[e] = cur[e]; }
        *(u32x4*)(Q + (size_t)(r0 + t) * 2048 + c0) = PACK8(y);
    }
}

constexpr int SGU_VLD = 520;
__device__ __forceinline__ void sgu_unit(KArgs kp, int l, int u, LAS unsigned char* lds, bool dry = false) {
    const Args A = load_args(kp);
    GAS unsigned char* ws = (GAS unsigned char*)A.ws; OPQ(ws); OPQ(l);
    const int tid = opq_tid(), lane = tid & 63, w = tid >> 6;
    bf16* Z = (bf16*)(ws + WS_Z);
    LAS bf16* VN = (LAS bf16*)lds;
    const size_t t0 = (size_t)u * 128;
    {
        u32x4 raw[16];
#pragma unroll
        for (int tt = 0; tt < 16; ++tt) raw[tt] = *(const u32x4*)(Z + (t0 + 16 * w + tt) * NZ + Z_SV + 8 * lane);
#pragma unroll
        for (int tt = 0; tt < 16; ++tt) *(LAS u32x4*)(VN + (16 * w + tt) * SGU_VLD + 8 * lane) = raw[tt];
        float g8[8], b8[8];
#pragma unroll
        for (int e = 0; e < 8; ++e) { g8[e] = A.sgu_ln_g[l * 512 + 8 * lane + e]; b8[e] = A.sgu_ln_b[l * 512 + 8 * lane + e]; }
#pragma unroll 1
        for (int tt = 0; tt < 16; ++tt) { const int t = 16 * w + tt;
            const u32x4 rv = *(const LAS u32x4*)(VN + t * SGU_VLD + 8 * lane); float f[8]; UNPACK8(rv, f);
            float sm = 0.f;
#pragma unroll
            for (int e = 0; e < 8; ++e) { f[e] = gelu_f(f[e]); sm += f[e]; }
            const float mean = wave_sum(sm) * (1.f / 512.f); float q = 0.f;
#pragma unroll
            for (int e = 0; e < 8; ++e) { f[e] -= mean; q += f[e] * f[e]; }
            const float rstd = frsq(wave_sum(q) * (1.f / 512.f) + LN_EPS);
#pragma unroll
            for (int e = 0; e < 8; ++e) f[e] = f[e] * rstd * g8[e] + b8[e];
            *(LAS u32x4*)(VN + t * SGU_VLD + 8 * lane) = PACK8(f);
        }
    }
    __syncthreads();
    const int fr = lane & 15, fq = lane >> 4, trow = 16 * w + fr;
    bf16* zr = Z + (t0 + trow) * NZ;
#pragma unroll 1
    for (int g = 0; g < 4; ++g) {
        f32x4 acc[8];
#pragma unroll
        for (int mt = 0; mt < 8; ++mt) acc[mt] = (f32x4){0.f, 0.f, 0.f, 0.f};
        u32x2 su2[8], sg2[8];
#pragma unroll
        for (int mt = 0; mt < 8; ++mt) { su2[mt] = *(const u32x2*)(zr + Z_SU + g * 128 + 16 * mt + 4 * fq); sg2[mt] = *(const u32x2*)(zr + Z_SG + g * 128 + 16 * mt + 4 * fq); }
        const float* wrow = A.w_spatial + (((size_t)l * 4 + g) * 128 + trow) * 128;
        const float bs = A.b_spatial[((size_t)l * 4 + g) * 128 + trow];
        for (int ks = 0; ks <= (w >> 1); ++ks) {
            const int s0 = 32 * ks + 8 * fq;
            const f32x4 wa = *(const f32x4*)(wrow + s0), wb = *(const f32x4*)(wrow + s0 + 4);
            float wf[8] = {wa[0], wa[1], wa[2], wa[3], wb[0], wb[1], wb[2], wb[3]};
#pragma unroll
            for (int e = 0; e < 8; ++e) wf[e] = (s0 + e <= trow) ? wf[e] : 0.f;
            const u32x4 bp = PACK8(wf); const bf16x8 bfrag = __builtin_bit_cast(bf16x8, bp);
#pragma unroll
            for (int mt = 0; mt < 8; ++mt) acc[mt] = mfma16(frag_ks(VN, SGU_VLD, 32 * ks, g * 128 + 16 * mt, lane), bfrag, acc[mt]);
        }
#pragma unroll
        for (int mt = 0; mt < 8; ++mt) {
            const float u0 = gelu_f(bflo(su2[mt].x)), u1 = gelu_f(bfhi(su2[mt].x)), u2 = gelu_f(bflo(su2[mt].y)), u3 = gelu_f(bfhi(su2[mt].y));
            const float g0 = silu_f(bflo(sg2[mt].x)), g1 = silu_f(bfhi(sg2[mt].x)), g2 = silu_f(bflo(sg2[mt].y)), g3 = silu_f(bfhi(sg2[mt].y));
            const u32x2 o = {pk2(u0 * (acc[mt][0] + bs) * g0, u1 * (acc[mt][1] + bs) * g1), pk2(u2 * (acc[mt][2] + bs) * g2, u3 * (acc[mt][3] + bs) * g3)};
            *(u32x2*)(dry ? (bf16*)ws + tid * 64 : zr + Z_SU + g * 128 + 16 * mt + 4 * fq) = o;
        }
    }
    __syncthreads();
}

constexpr int AT_LD = 72, AT_PLD = 168;
constexpr int AT_Q = 0, AT_K = AT_Q + 128 * AT_LD * 2, AT_V = AT_K + 256 * AT_LD * 2, AT_P = AT_V + 272 * AT_LD * 2, AT_END = AT_P + 8 * 16 * AT_PLD * 2;
static_assert(AT_END <= LDS_BYTES, "attention LDS");
struct AttnId { int g, b, h, r, n, d, hc; };
__device__ __forceinline__ AttnId attn_decode(int slot) {
    const int u = (slot & ~63) | ((slot & 7) << 3) | ((slot >> 3) & 7);
    AttnId a; a.g = u >> 11; const int rem = u & 2047; a.b = rem >> 8; a.h = (rem >> 5) & 7; const int rn = rem & 31;
    const int dsh = 2 * a.g, nbsh = 5 - dsh; a.d = 1 << dsh; a.r = rn >> nbsh; a.n = rn & ((1 << nbsh) - 1); a.hc = (a.g * 8 + a.h) * 64; return a;
}
__device__ __forceinline__ void attn_issue(const bf16* Z, const int* posp, const AttnId& a, int tid, u32x4 (&pr)[11], int& ppos) {
    const size_t tokb = (size_t)a.b * SEQ;
#pragma unroll
    for (int i = 0; i < 11; ++i) pr[i] = (u32x4){0u, 0u, 0u, 0u};
    ppos = 0;
    if (tid < 384) {
        const int isK = tid >= 128, idx = isK ? tid - 128 : tid, isub = isK ? 128 * (a.n - 1) + idx : 128 * a.n + idx;
        if (isub >= 0) { const size_t tok = tokb + (size_t)isub * a.d + a.r; const bf16* src = Z + tok * NZ + (isK ? Z_AK : Z_AQ) + a.hc;
            pr[0] = *(const u32x4*)src; pr[1] = *(const u32x4*)(src + 8); ppos = posp[tok]; }
    }
#pragma unroll
    for (int k = 0; k < 5; ++k) { const int idx = tid + 512 * k;
        if (idx < 2304) { const int row = idx / 6, ch = 2 + idx % 6, isK = row >= 128, ri = isK ? row - 128 : row, isub = isK ? 128 * (a.n - 1) + ri : 128 * a.n + ri;
            if (isub >= 0) pr[2 + k] = *(const u32x4*)(Z + (tokb + (size_t)isub * a.d + a.r) * NZ + (isK ? Z_AK : Z_AQ) + a.hc + 8 * ch); } }
#pragma unroll
    for (int k = 0; k < 4; ++k) { const int idx = tid + 512 * k, row = idx >> 3, ch = idx & 7, isub = 128 * (a.n - 1) + row;
        if (isub >= 0) pr[7 + k] = *(const u32x4*)(Z + (tokb + (size_t)isub * a.d + a.r) * NZ + Z_AV + a.hc + 8 * ch); }
}
__device__ __forceinline__ void attn_commit(LAS unsigned char* lds, int tid, const u32x4 (&pr)[11], int ppos) {
    LAS bf16* Qs = (LAS bf16*)(lds + AT_Q); LAS bf16* Ks = (LAS bf16*)(lds + AT_K); LAS bf16* Vs = (LAS bf16*)(lds + AT_V);
    if (tid < 384) {
        const int isK = tid >= 128, idx = isK ? tid - 128 : tid;
        LAS bf16* dst = (isK ? Ks : Qs) + idx * AT_LD;
        float t1[8], t2[8]; UNPACK8(pr[0], t1); UNPACK8(pr[1], t2);
        const float pos = (float)ppos;
        const float invf[8] = {1.0f, 0.19392274474868576f, 0.03760603093086393f, 0.007292664737217109f, 0.001414213562373095f, 0.0002742481756762073f, 5.318295896944988e-05f, 1.031338537721246e-05f};
#pragma unroll
        for (int i = 0; i < 8; ++i) {
            const float ang = pos * invf[i], k = rintf(ang * 0.15915494309189535f);
            float rr = fmaf(-k, 6.2831854820251465f, ang); rr = fmaf(-k, -1.7484555e-7f, rr);
            const float cs = __cosf(rr), sn = __sinf(rr);
            const float a1 = t1[i] * cs - t2[i] * sn, a2 = t2[i] * cs + t1[i] * sn; t1[i] = a1; t2[i] = a2;
        }
        *(LAS u32x4*)dst = PACK8(t1); *(LAS u32x4*)(dst + 8) = PACK8(t2);
    }
#pragma unroll
    for (int k = 0; k < 5; ++k) { const int idx = tid + 512 * k;
        if (idx < 2304) { const int row = idx / 6, ch = 2 + idx % 6, isK = row >= 128, ri = isK ? row - 128 : row;
            *(LAS u32x4*)((isK ? Ks : Qs) + ri * AT_LD + 8 * ch) = pr[2 + k]; } }
#pragma unroll
    for (int k = 0; k < 4; ++k) { const int idx = tid + 512 * k, row = idx >> 3, ch = idx & 7; *(LAS u32x4*)(Vs + row * AT_LD + 8 * ch) = pr[7 + k]; }
}
__device__ __forceinline__ bf16x8 frag_ks_pair(const LAS bf16* base, int ld, int k0, int r0, int lane) {
    const int g = lane >> 4, q = (lane & 15) >> 2, p = lane & 3;
    const LAS bf16* a = base + (k0 + 4 * g + q) * ld + r0 + 4 * p;
    const s16x4 lo = tr_rd(a), hi = tr_rd(a + 16 * ld);
    return (bf16x8){lo[0], lo[1], lo[2], lo[3], hi[0], hi[1], hi[2], hi[3]};
}
__device__ __forceinline__ void attn_compute(bf16* Z, float* LSE, const AttnId& a, LAS unsigned char* lds, int tid, bool dry, unsigned char* ws) {
    const int lane = tid & 63, w = tid >> 6, fr = lane & 15, fq = lane >> 4, n = a.n;
    LAS bf16* Qs = (LAS bf16*)(lds + AT_Q); LAS bf16* Ks = (LAS bf16*)(lds + AT_K); LAS bf16* Vs = (LAS bf16*)(lds + AT_V);
    const bf16x8 q0 = frag_kc(Qs, AT_LD, 16 * w, 0, lane), q1 = frag_kc(Qs, AT_LD, 16 * w, 32, lane);
    f32x4 s[10];
    float mx = -INFINITY;
#pragma unroll
    for (int t3 = 0; t3 < 3; ++t3) {
        bf16x8 kf[3][2];
#pragma unroll
        for (int i = 0; i < 3; ++i) { kf[i][0] = frag_kc(Ks, AT_LD, 16 * (w + 3 * t3 + i), 0, lane); kf[i][1] = frag_kc(Ks, AT_LD, 16 * (w + 3 * t3 + i), 32, lane); }
        __builtin_amdgcn_sched_barrier(0);
#pragma unroll
        for (int i = 0; i < 3; ++i) { f32x4 acc = {0.f, 0.f, 0.f, 0.f}; acc = mfma16(kf[i][0], q0, acc); acc = mfma16(kf[i][1], q1, acc); s[3 * t3 + i] = acc; }
    }
#pragma unroll
    for (int tt = 0; tt < 9; ++tt) { const int kt = w + tt;
        f32x4 acc = s[tt];
        const bool tile_ok = (n > 0) || (kt >= 8);
#pragma unroll
        for (int j = 0; j < 4; ++j) { const int dl = fr - 4 * fq - j; const bool ok = tile_ok && (tt == 0 ? dl <= 0 : (tt == 8 ? dl >= 0 : true));
            acc[j] = ok ? acc[j] * 0.125f : -INFINITY; mx = fmaxf(mx, acc[j]); }
        s[tt] = acc;
    }
    mx = fmaxf(mx, __shfl_xor(mx, 16)); mx = fmaxf(mx, __shfl_xor(mx, 32));
    float ls = 0.f;
#pragma unroll
    for (int tt = 0; tt < 9; ++tt)
#pragma unroll
        for (int j = 0; j < 4; ++j) { const float p = fexp(s[tt][j] - mx); ls += p; s[tt][j] = p; }
    s[9] = (f32x4){0.f, 0.f, 0.f, 0.f};
    ls += __shfl_xor(ls, 16); ls += __shfl_xor(ls, 32);
    f32x4 o[4];
#pragma unroll
    for (int nt = 0; nt < 4; ++nt) o[nt] = (f32x4){0.f, 0.f, 0.f, 0.f};
#pragma unroll
    for (int k2 = 0; k2 < 5; ++k2) {
        const u32x4 pp = {pk2(s[2 * k2][0], s[2 * k2][1]), pk2(s[2 * k2][2], s[2 * k2][3]), pk2(s[2 * k2 + 1][0], s[2 * k2 + 1][1]), pk2(s[2 * k2 + 1][2], s[2 * k2 + 1][3])};
        const bf16x8 pf = __builtin_bit_cast(bf16x8, pp);
        bf16x8 vf[4];
#pragma unroll
        for (int nt = 0; nt < 4; ++nt) vf[nt] = frag_ks_pair(Vs, AT_LD, 16 * (w + 2 * k2), 16 * nt, lane);
        __builtin_amdgcn_sched_barrier(0);
#pragma unroll
        for (int nt = 0; nt < 4; ++nt) o[nt] = mfma16(vf[nt], pf, o[nt]); }
    const int isub = 128 * n + 16 * w + fr; const size_t tok = (size_t)a.b * SEQ + (size_t)isub * a.d + a.r; const float inv = frcp(ls);
    bf16* orow = dry ? (bf16*)ws + tid * 64 : Z + tok * NZ + Z_AQ + a.hc;
#pragma unroll
    for (int nt = 0; nt < 4; ++nt) *(u32x2*)(orow + 16 * nt + 4 * fq) = (u32x2){pk2(o[nt][0] * inv, o[nt][1] * inv), pk2(o[nt][2] * inv, o[nt][3] * inv)};
    if (fq == 0) (dry ? (float*)ws + 65536 + tid : LSE + tok * 24 + a.g * 8 + a.h)[0] = mx + flog(ls);
}
__device__ __forceinline__ void attn_phase(KArgs kp, LAS unsigned char* lds, int G, bool dry = false) {
    const Args A = load_args(kp);
    GAS unsigned char* ws = (GAS unsigned char*)A.ws; OPQ(ws);
    const int tid = opq_tid();
    bf16* Z = (bf16*)(ws + WS_Z); float* LSE = (float*)(ws + WS_LSE);
    constexpr int N_ATT = 6144;
    if (tid < 128) { const int row = 256 + (tid >> 3), ch = tid & 7; unsigned z = 0u; asm volatile("" : "+v"(z)); *(LAS u32x4*)((LAS bf16*)(lds + AT_V) + row * AT_LD + 8 * ch) = (u32x4){z, z, z, z}; }
    u32x4 pr[11]; int ppos;
    int it = blockIdx.x;
    AttnId cur = attn_decode(it < N_ATT ? it : 0);
    if (it < N_ATT) attn_issue(Z, A.pos, cur, tid, pr, ppos);
    for (; it < N_ATT; it += G) {
        attn_commit(lds, tid, pr, ppos);
        __syncthreads();
        const int nx = it + G;
        const AttnId nxt = attn_decode(nx < N_ATT ? nx : 0);
        if (nx < N_ATT) attn_issue(Z, A.pos, nxt, tid, pr, ppos);
        attn_compute(Z, LSE, cur, lds, tid, dry, (unsigned char*)ws);
        __syncthreads();
        cur = nxt;
    }
}

constexpr int ML_KLD = 264, ML_VLD = 48, ML_CLD = 264;
constexpr int ML_K = 0, ML_V = ML_K + 128 * ML_KLD * 2, ML_VW = ML_V + 128 * ML_VLD * 2, ML_C = ML_VW + 128 * ML_VLD * 2, ML_S = ML_C + 48 * ML_CLD * 2, ML_SBUF = 6 * 128 * 4, ML_G = ML_S + 2 * ML_SBUF, ML_END = ML_G + 4096 * 8;
static_assert(ML_END <= LDS_BYTES - 64, "mlstm LDS");
__device__ __forceinline__ float mlstm_scalars(LAS float* sb, float ig0, float ig1, float f0, float f1, float mcar, int lane) {
    const float lf0 = fminf(f0, 0.f) - log1pf(fexp(-fabsf(f0))), lf1 = fminf(f1, 0.f) - log1pf(fexp(-fabsf(f1)));
    const float pr = lf0 + lf1; float inc = pr;
#pragma unroll
    for (int o = 1; o < 64; o <<= 1) { const float t = __shfl_up(inc, o); if (lane >= o) inc += t; }
    const float b0 = inc - pr + lf0, b1 = inc;
    const float u0 = ig0 - b0, u1 = ig1 - b1;
    float pmx = fmaxf(u0, u1);
#pragma unroll
    for (int o = 1; o < 64; o <<= 1) { const float t = __shfl_up(pmx, o); if (lane >= o) pmx = fmaxf(pmx, t); }
    float ex = __shfl_up(pmx, 1); if (lane == 0) ex = -INFINITY;
    const float pm0 = fmaxf(ex, u0), pm1 = pmx;
    const float mt0 = b0 + fmaxf(mcar, pm0), mt1 = b1 + fmaxf(mcar, pm1);
    const float gtot = __shfl(b1, 63), pmall = __shfl(pm1, 63);
    const float mnew = fmaxf(gtot + mcar, gtot + pmall);
    sb[2 * lane] = b0; sb[2 * lane + 1] = b1; sb[128 + 2 * lane] = u0; sb[128 + 2 * lane + 1] = u1; sb[256 + 2 * lane] = mt0; sb[256 + 2 * lane + 1] = mt1;
    sb[384 + 2 * lane] = fexp(b0 + mcar - mt0); sb[384 + 2 * lane + 1] = fexp(b1 + mcar - mt1);
    sb[512 + 2 * lane] = fexp(gtot + u0 - mnew); sb[512 + 2 * lane + 1] = fexp(gtot + u1 - mnew);
    if (lane == 0) sb[640] = fexp(gtot + mcar - mnew);
    return mnew;
}
__device__ __forceinline__ void mlstm_unit(KArgs kp, int l, int u, LAS unsigned char* lds, bool dry = false) {
    const Args A = load_args(kp);
    GAS unsigned char* ws = (GAS unsigned char*)A.ws; OPQ(ws); OPQ(l);
    const int tid = opq_tid(), lane = tid & 63, w = tid >> 6, fr = lane & 15, fq = lane >> 4;
    const int pr_ = (u & 7) * 4 + (u >> 6), js = (u >> 3) & 7, b = pr_ >> 2, h = pr_ & 3;
    bf16* Z = (bf16*)(ws + WS_Z); const bf16* QKC = (const bf16*)(ws + WS_XB); const float* GT = (const float*)(ws + WS_GATES);
    LAS bf16* Ks = (LAS bf16*)(lds + ML_K); LAS bf16* Vs = (LAS bf16*)(lds + ML_V); LAS bf16* Vw = (LAS bf16*)(lds + ML_VW); LAS bf16* CsT = (LAS bf16*)(lds + ML_C);
    const float bi = A.b_igate[l * 4 + h], bfg = A.b_fgate[l * 4 + h];
    f32x4 st[2][3];
#pragma unroll
    for (int a = 0; a < 2; ++a)
#pragma unroll
        for (int c = 0; c < 3; ++c) st[a][c] = (f32x4){0.f, 0.f, 0.f, 0.f};
    float mcar = -INFINITY;
    const size_t tb = (size_t)b * SEQ;
    const int vs = tid >> 2, vch = tid & 3;
    u32x4 kreg[8]; u32x4 vraw; bf16x8 qf[8];
    LAS f32x2_t* gl = (LAS f32x2_t*)(lds + ML_G);
    {   float ga[8], gb[8];
#pragma unroll
        for (int k = 0; k < 8; ++k) { const float* gp = GT + (tb + tid + 512 * k) * 8; ga[k] = gp[h]; gb[k] = gp[4 + h]; }
#pragma unroll
        for (int k = 0; k < 8; ++k) gl[tid + 512 * k] = (f32x2_t){ga[k] + bi, gb[k] + bfg};
    }
#pragma unroll
    for (int k = 0; k < 8; ++k) { const int idx = tid + 512 * k, sr = idx >> 5, ch = idx & 31; kreg[k] = *(const u32x4*)(QKC + (tb + sr) * 2048 + 1024 + h * 256 + 8 * ch); }
    vraw = *(const u32x4*)(Z + (tb + vs) * NZ + Z_MV + h * 256 + 32 * js + 8 * vch);
    { const bf16* qp = QKC + (tb + 16 * w + fr) * 2048 + h * 256 + 8 * fq;
#pragma unroll
      for (int ks = 0; ks < 8; ++ks) qf[ks] = __builtin_bit_cast(bf16x8, *(const u32x4*)(qp + 32 * ks)); }
    __syncthreads();
    if (w == 0) { const f32x2_t g0 = gl[2 * lane], g1 = gl[2 * lane + 1]; mcar = mlstm_scalars((LAS float*)(lds + ML_S), g0.x, g1.x, g0.y, g1.y, mcar, lane); }
    __syncthreads();
#pragma unroll 1
    for (int c = 0; c < 32; ++c) {
        const size_t t0 = tb + (size_t)c * 128, t1 = t0 + 128;
        const bool more = c < 31;
        LAS float* sb = (LAS float*)(lds + ML_S + (c & 1) * ML_SBUF); LAS float* sbn = (LAS float*)(lds + ML_S + ((c + 1) & 1) * ML_SBUF);
#pragma unroll
        for (int k = 0; k < 8; ++k) { const int idx = tid + 512 * k, sr = idx >> 5, ch = idx & 31; *(LAS u32x4*)(Ks + sr * ML_KLD + 8 * ch) = kreg[k]; }
        *(LAS u32x4*)(Vs + vs * ML_VLD + 8 * vch) = vraw;
        {   const float wt = sb[512 + vs]; float f[8]; UNPACK8(vraw, f);
#pragma unroll
            for (int e = 0; e < 8; ++e) f[e] *= wt;
            *(LAS u32x4*)(Vw + vs * ML_VLD + 8 * vch) = PACK8(f); }
        if (tid < 256) { const int sr = tid >> 1, ch = 4 + (tid & 1);
            *(LAS u32x4*)(Vs + sr * ML_VLD + 8 * ch) = (u32x4){(ch == 4) ? 0x3f80u : 0u, 0u, 0u, 0u};
            *(LAS u32x4*)(Vw + sr * ML_VLD + 8 * ch) = (u32x4){(ch == 4) ? f2bf(sb[512 + sr]) : 0u, 0u, 0u, 0u}; }
        __syncthreads();
        if (more) {
#pragma unroll
            for (int k = 0; k < 8; ++k) { const int idx = tid + 512 * k, sr = idx >> 5, ch = idx & 31; kreg[k] = *(const u32x4*)(QKC + (t1 + sr) * 2048 + 1024 + h * 256 + 8 * ch); }
            vraw = *(const u32x4*)(Z + (t1 + vs) * NZ + Z_MV + h * 256 + 32 * js + 8 * vch);
        }
        const int tq = 16 * w + fr;
        const float btq = sb[tq], mtq = sb[256 + tq], itr = sb[384 + tq];
        f32x4 num[3], qc[3];
#pragma unroll
        for (int nt = 0; nt < 3; ++nt) { num[nt] = (f32x4){0.f, 0.f, 0.f, 0.f}; qc[nt] = (f32x4){0.f, 0.f, 0.f, 0.f}; }
#pragma unroll 1
        for (int k2 = 0; k2 <= (w >> 1); ++k2) {
            u32x4 pp;
            {   f32x4 a0 = {0.f, 0.f, 0.f, 0.f};
                bf16x8 kf[8];
#pragma unroll
                for (int ks = 0; ks < 8; ++ks) kf[ks] = frag_kc(Ks, ML_KLD, 32 * k2, 32 * ks, lane);
                __builtin_amdgcn_sched_barrier(0);
#pragma unroll
                for (int ks = 0; ks < 8; ++ks) a0 = mfma16(kf[ks], qf[ks], a0);
                const f32x4 us = *(const LAS f32x4*)(sb + 128 + 32 * k2 + 4 * fq);
                const bool diag = (2 * k2 == w);
                float p[4];
#pragma unroll
                for (int j = 0; j < 4; ++j) p[j] = (!diag || 4 * fq + j <= fr) ? a0[j] * fexp(btq + us[j] - mtq) : 0.f;
                pp.x = pk2(p[0], p[1]); pp.y = pk2(p[2], p[3]); }
            if (2 * k2 + 1 <= w) {
                f32x4 a1 = {0.f, 0.f, 0.f, 0.f};
                bf16x8 kf[8];
#pragma unroll
                for (int ks = 0; ks < 8; ++ks) kf[ks] = frag_kc(Ks, ML_KLD, 32 * k2 + 16, 32 * ks, lane);
                __builtin_amdgcn_sched_barrier(0);
#pragma unroll
                for (int ks = 0; ks < 8; ++ks) a1 = mfma16(kf[ks], qf[ks], a1);
                const f32x4 us = *(const LAS f32x4*)(sb + 128 + 32 * k2 + 16 + 4 * fq);
                const bool diag = (2 * k2 + 1 == w);
                float p[4];
#pragma unroll
                for (int j = 0; j < 4; ++j) p[j] = (!diag || 4 * fq + j <= fr) ? a1[j] * fexp(btq + us[j] - mtq) : 0.f;
                pp.z = pk2(p[0], p[1]); pp.w = pk2(p[2], p[3]);
            } else { pp.z = 0u; pp.w = 0u; }
            const bf16x8 pf = __builtin_bit_cast(bf16x8, pp);
#pragma unroll
            for (int nt = 0; nt < 3; ++nt) num[nt] = mfma16(frag_ks_pair(Vs, ML_VLD, 32 * k2, 16 * nt, lane), pf, num[nt]);
        }
        if (more && w == 0) { const f32x2_t g0 = gl[(c + 1) * 128 + 2 * lane], g1 = gl[(c + 1) * 128 + 2 * lane + 1]; mcar = mlstm_scalars(sbn, g0.x, g1.x, g0.y, g1.y, mcar, lane); }
        if (c > 0) {
#pragma unroll
            for (int kh = 0; kh < 4; ++kh) {
                bf16x8 cf[2][3];
#pragma unroll
                for (int k1 = 0; k1 < 2; ++k1)
#pragma unroll
                    for (int nt = 0; nt < 3; ++nt) cf[k1][nt] = frag_kc(CsT, ML_CLD, 16 * nt, 32 * (2 * kh + k1), lane);
                __builtin_amdgcn_sched_barrier(0);
#pragma unroll
                for (int k1 = 0; k1 < 2; ++k1)
#pragma unroll
                    for (int nt = 0; nt < 3; ++nt) qc[nt] = mfma16(cf[k1][nt], qf[2 * kh + k1], qc[nt]);
            }
        }
        if (more) { const bf16* qp = QKC + (t1 + 16 * w + fr) * 2048 + h * 256 + 8 * fq;
#pragma unroll
            for (int ks = 0; ks < 8; ++ks) qf[ks] = __builtin_bit_cast(bf16x8, *(const u32x4*)(qp + 32 * ks)); }
        {
            const float dd = num[2][0] + itr * qc[2][0]; const float den = __shfl(dd, fr);
            const float inv = frcp(fmaxf(fabsf(den), fexp(-mtq)));
            bf16* hp = dry ? (bf16*)ws + tid * 64 : Z + (t0 + tq) * NZ + Z_MV + h * 256 + 32 * js;
#pragma unroll
            for (int nt = 0; nt < 2; ++nt) *(u32x2*)(hp + 16 * nt + 4 * fq) = (u32x2){pk2((num[nt][0] + itr * qc[nt][0]) * inv, (num[nt][1] + itr * qc[nt][1]) * inv), pk2((num[nt][2] + itr * qc[nt][2]) * inv, (num[nt][3] + itr * qc[nt][3]) * inv)};
        }
        {
            const float dec = sb[640];
#pragma unroll
            for (int a = 0; a < 2; ++a)
#pragma unroll
                for (int nt = 0; nt < 3; ++nt) st[a][nt] = st[a][nt] * dec;
#pragma unroll
            for (int ks = 0; ks < 4; ++ks) {
                bf16x8 bfr[3];
#pragma unroll
                for (int nt = 0; nt < 3; ++nt) bfr[nt] = frag_ks(Vw, ML_VLD, 32 * ks, 16 * nt, lane);
#pragma unroll
                for (int a = 0; a < 2; ++a) { const bf16x8 af = frag_ks(Ks, ML_KLD, 32 * ks, 32 * w + 16 * a, lane);
#pragma unroll
                    for (int nt = 0; nt < 3; ++nt) st[a][nt] = mfma16(af, bfr[nt], st[a][nt]); }
            }
        }
        __syncthreads();
#pragma unroll
        for (int a = 0; a < 2; ++a)
#pragma unroll
            for (int nt = 0; nt < 3; ++nt)
                *(LAS u32x2*)(CsT + (16 * nt + fr) * ML_CLD + 32 * w + 16 * a + 4 * fq) = (u32x2){pk2(st[a][nt][0], st[a][nt][1]), pk2(st[a][nt][2], st[a][nt][3])};
    }
    __syncthreads();
}

__device__ __forceinline__ void finish_phase(KArgs kp, int l, int G) {
    const Args A = load_args(kp);
    GAS unsigned char* ws = (GAS unsigned char*)A.ws; OPQ(ws); OPQ(l);
    const int tid = opq_tid(), lane = tid & 63, wave = tid >> 6, gw = blockIdx.x * 8 + wave, NGW = G * 8;
    const bf16* Z = (const bf16*)(ws + WS_Z); const float* LSE = (const float*)(ws + WS_LSE); bf16* MIX = (bf16*)(ws + WS_XB);
    float hg[16];
#pragma unroll
    for (int e = 0; e < 16; ++e) hg[e] = A.head_norm_g[l * 1024 + 16 * lane + e];
    for (int m = gw; m < M; m += NGW) {
        const bf16* zr = Z + (size_t)m * NZ; bf16* mr = MIX + (size_t)m * 2048;
        {
            const int hh = lane >> 3; const float* lp = LSE + (size_t)m * 24 + hh;
            const float l0 = lp[0], l1 = lp[8], l2 = lp[16], mx = fmaxf(l0, fmaxf(l1, l2));
            float e0 = fexp(l0 - mx), e1 = fexp(l1 - mx), e2 = fexp(l2 - mx); const float inv = frcp(e0 + e1 + e2); e0 *= inv; e1 *= inv; e2 *= inv;
            const u32x4 r0 = *(const u32x4*)(zr + Z_AQ + 8 * lane), r1 = *(const u32x4*)(zr + Z_AQ + 512 + 8 * lane), r2 = *(const u32x4*)(zr + Z_AQ + 1024 + 8 * lane), rg = *(const u32x4*)(zr + Z_AG + 8 * lane);
            float o0[8], o1[8], o2[8], gg[8], y[8]; UNPACK8(r0, o0); UNPACK8(r1, o1); UNPACK8(r2, o2); UNPACK8(rg, gg);
#pragma unroll
            for (int e = 0; e < 8; ++e) y[e] = (e0 * o0[e] + e1 * o1[e] + e2 * o2[e]) * silu_f(gg[e]);
            *(u32x4*)(mr + 8 * lane) = PACK8(y);
        }
        *(u32x4*)(mr + 512 + 8 * lane) = *(const u32x4*)(zr + Z_SU + 8 * lane);
        {
            float x[16], gm[16];
#pragma unroll
            for (int c2 = 0; c2 < 2; ++c2) { const u32x4 hv = *(const u32x4*)(zr + Z_MV + 16 * lane + 8 * c2), ov = *(const u32x4*)(zr + Z_MO + 16 * lane + 8 * c2), gv = *(const u32x4*)(zr + Z_MG + 16 * lane + 8 * c2);
                float hf[8], of[8], gf[8]; UNPACK8(hv, hf); UNPACK8(ov, of); UNPACK8(gv, gf);
#pragma unroll
                for (int e = 0; e < 8; ++e) { x[8 * c2 + e] = hf[e] * sigmoid_f(of[e]); gm[8 * c2 + e] = gf[e]; } }
            float s = 0.f;
#pragma unroll
            for (int e = 0; e < 16; ++e) s += x[e];
            const float mean = sum16(s) * (1.f / 256.f); float q = 0.f;
#pragma unroll
            for (int e = 0; e < 16; ++e) { x[e] -= mean; q += x[e] * x[e]; }
            const float rstd = frsq(sum16(q) * (1.f / 256.f) + LN_EPS);
            float y0[8], y1[8];
#pragma unroll
            for (int e = 0; e < 8; ++e) { y0[e] = x[e] * rstd * hg[e] * silu_f(gm[e]); y1[e] = x[8 + e] * rstd * hg[8 + e] * silu_f(gm[8 + e]); }
            *(u32x4*)(mr + 1024 + 16 * lane) = PACK8(y0); *(u32x4*)(mr + 1024 + 16 * lane + 8) = PACK8(y1);
        }
    }
}

__device__ __forceinline__ void ln_phase(KArgs kp, int l, int G, LAS unsigned char* lds) {
    const Args A = load_args(kp);
    GAS unsigned char* ws = (GAS unsigned char*)A.ws; OPQ(ws); OPQ(l);
    const int tid = opq_tid(), lane = tid & 63, wave = tid >> 6, gw = blockIdx.x * 8 + wave, NGW = G * 8;
    const bool more = (l + 1 < DEPTH);
    LAS f32x4* wg = (LAS f32x4*)lds;
    if (more) { load_gate_w(A.w_in + (size_t)(l + 1) * D * DIN, wg); }
    __syncthreads();
    bf16* XB = (bf16*)(ws + WS_XB); float* GT = (float*)(ws + WS_GATES);
    f32x4 gv[8], bv[8];
#pragma unroll
    for (int i = 0; i < 8; ++i) { gv[i] = *((const f32x4*)(A.ln_g + (size_t)l * D) + lane + 64 * i); bv[i] = *((const f32x4*)(A.ln_b + (size_t)l * D) + lane + 64 * i); }
    for (int m = gw; m < M; m += NGW) {
        f32x4* xr = (f32x4*)(A.out + (size_t)m * D) + lane;
        const u32x2* tr = (const u32x2*)((const bf16*)(ws + WS_Z) + (size_t)m * D) + lane;
        const f32x4* rr = (const f32x4*)((l == 0 ? A.x : (const float*)A.out) + (size_t)m * D) + lane;
        f32x4 v[8]; float s = 0.f;
#pragma unroll
        for (int i = 0; i < 8; ++i) { const u32x2 t2 = tr[64 * i]; const f32x4 rs = rr[64 * i];
            v[i] = rs * 1.41421356237f + (f32x4){bflo(t2.x), bfhi(t2.x), bflo(t2.y), bfhi(t2.y)}; s += (v[i][0] + v[i][1]) + (v[i][2] + v[i][3]); }
        const float mean = wave_sum(s) * (1.f / D); float q = 0.f;
#pragma unroll
        for (int i = 0; i < 8; ++i) { v[i] = v[i] - mean; q += (v[i][0] * v[i][0] + v[i][1] * v[i][1]) + (v[i][2] * v[i][2] + v[i][3] * v[i][3]); }
        const float rstd = frsq(wave_sum(q) * (1.f / D) + LN_EPS);
#pragma unroll
        for (int i = 0; i < 8; ++i) { v[i] = v[i] * rstd * gv[i] + bv[i]; xr[64 * i] = v[i]; }
        if (more) {
            u32x2* o = (u32x2*)(XB + (size_t)m * D) + lane;
#pragma unroll
            for (int i = 0; i < 8; ++i) o[64 * i] = (u32x2){pk2(v[i][0], v[i][1]), pk2(v[i][2], v[i][3])};
            gate_dots(v, wg, GT + (size_t)m * 8, lane);
        }
    }
    __syncthreads();
}

constexpr size_t WS_BAR = 512 * 1024;
constexpr int LDS_MISC = LDS_BYTES - 64;
#define XB_TMO      128
#define XB_XCNT(j)  (256  + 64 * (j))
#define XB_XSUB(j)  (1280 + 64 * (j))
#define XB_XGEN(j)  (2304 + 64 * (j))
#define XB_TOP      3328
#define XB_TOPGEN   3392
#define XCD_BAR_WORDS 3456
#define XB_SPIN_CAP (1u << 18)

__device__ __forceinline__ unsigned xb_ld(unsigned* p)              { return __hip_atomic_load(p, __ATOMIC_RELAXED, __HIP_MEMORY_SCOPE_AGENT); }
__device__ __forceinline__ unsigned xb_add(unsigned* p, unsigned v) { return __hip_atomic_fetch_add(p, v, __ATOMIC_RELAXED, __HIP_MEMORY_SCOPE_AGENT); }
__device__ __forceinline__ unsigned xb_xcc_id() { return (unsigned)__builtin_amdgcn_s_getreg((3 << 11) | 20) & 0xFu; }
#define XB_SPIN(cond, bar) do { unsigned _sp = 0; while (cond) { __builtin_amdgcn_s_sleep(1); \
    if ((++_sp & 255u) == 0u) { if (xb_ld(&(bar)[XB_TMO])) break; if (_sp > XB_SPIN_CAP) { atomicAdd(&(bar)[XB_TMO], 1u); break; } } } } while (0)

struct XcdBarrier {
    unsigned* bar; unsigned x;
    volatile LAS unsigned* st;
};

__device__ __forceinline__ XcdBarrier xcd_barrier_post(unsigned* bar, volatile LAS unsigned* st) {
    XcdBarrier b; b.bar = bar; b.x = xb_xcc_id(); b.st = st;
    if (threadIdx.x == 0) (void)xb_add(&bar[XB_XCNT(b.x)], 1u);
    return b;
}
__device__ __forceinline__ void xcd_barrier_complete(unsigned* bar, unsigned x, unsigned& nloc, unsigned& nx) {
    const unsigned G = gridDim.x * gridDim.y * gridDim.z;
    unsigned sum, cnt, mine, sp = 0u;
    for (;;) {
        sum = 0u; cnt = 0u; mine = 0u;
#pragma unroll
        for (unsigned j = 0; j < 16; ++j) { const unsigned c = xb_ld(&bar[XB_XCNT(j)]); sum += c; cnt += (c > 0u) ? 1u : 0u; mine = (j == x) ? c : mine; }
        if (sum == G) break;
        __builtin_amdgcn_s_sleep(1);
        if ((++sp & 255u) == 0u) { if (xb_ld(&bar[XB_TMO])) break; if (sp > XB_SPIN_CAP) { atomicAdd(&bar[XB_TMO], 1u); break; } }
    }
    nloc = mine > 0u ? mine : 1u; nx = cnt > 0u ? cnt : 1u;
}

__device__ __forceinline__ void xcd_barrier(const XcdBarrier& b) {
    asm volatile("s_waitcnt vmcnt(0)" ::: "memory");
    __syncthreads();
    if (threadIdx.x == 0) {
        unsigned* bar = b.bar;
        __builtin_amdgcn_s_waitcnt(0);
        unsigned nloc = b.st[0], nx = b.st[1];
        if (nloc == 0u) { xcd_barrier_complete(bar, b.x, nloc, nx); b.st[0] = nloc; b.st[1] = nx; }
        const unsigned old = xb_add(&bar[XB_XSUB(b.x)], 1u);
        const unsigned gen = old / nloc;
        if (old + 1u == (gen + 1u) * nloc) {
            __builtin_amdgcn_fence(__ATOMIC_RELEASE, "agent");
            asm volatile("s_waitcnt vmcnt(0)" ::: "memory");
            const unsigned og = xb_add(&bar[XB_TOP], 1u);
            const unsigned tg = og / nx;
            if (og + 1u == (tg + 1u) * nx) xb_add(&bar[XB_TOPGEN], 1u);
            else XB_SPIN(xb_ld(&bar[XB_TOPGEN]) == tg, bar);
            __builtin_amdgcn_fence(__ATOMIC_ACQUIRE, "agent");
            xb_add(&bar[XB_XGEN(b.x)], 1u);
            asm volatile("s_waitcnt vmcnt(0)" ::: "memory");
        } else {
            XB_SPIN(xb_ld(&bar[XB_XGEN(b.x)]) == gen, bar);
            __builtin_amdgcn_fence(__ATOMIC_ACQUIRE, "agent");
            asm volatile("s_waitcnt vmcnt(0)" ::: "memory");
        }
    }
    __syncthreads();
}


__global__ void __launch_bounds__(512, 2) fwd_megakernel(Args A_unused) {
    const KArgs kp = (KArgs)__builtin_amdgcn_kernarg_segment_ptr();
    extern __shared__ __attribute__((aligned(16))) unsigned char lds_raw[];
    LAS unsigned char* lds = (LAS unsigned char*)lds_raw;
    cg::grid_group grid = cg::this_grid();
    const int G = gridDim.x, bid = blockIdx.x;
    if (threadIdx.x < 16) ((LAS unsigned*)(lds + LDS_MISC))[threadIdx.x] = 0u;
    __syncthreads();
    XcdBarrier xbar;
    { const Args A0 = load_args(kp); xbar = xcd_barrier_post((unsigned*)(A0.ws + WS_BAR), (volatile LAS unsigned*)(lds + LDS_MISC)); }
#define GRID_SYNC() xcd_barrier(xbar)
#ifndef NO_P0
    p0_prologue(kp, lds, G);
#endif
#ifdef PROBE_P0
    GRID_SYNC(); p0_prologue(kp, lds, G);
#endif
    grid.sync();
#pragma unroll
    for (int l = 0; l < DEPTH; ++l) {
        {
            const Args A = load_args(kp);
            pg8::Gemm g{(const pg8::bf16_t*)(A.ws + WS_XB), (const pg8::bf16_t*)(A.ws + WS_WIN + l * WIN_BYTES), M, NZ, D};
            pg8::StaticOrder S; S.init(M, NZ, G, bid);
            pg8::EpiBf16<0> E{(pg8::bf16_t*)(A.ws + WS_Z), NZ, nullptr, 0, 0, 1.f};
#ifndef NO_G1
            pg8::gemm_phase<pg8::EpiBf16<0>, pg8::StaticOrder, true, true>(lds, g, S, E);
#endif
#ifdef PROBE_G1
            GRID_SYNC(); pg8::gemm_phase<pg8::EpiBf16<0>, pg8::StaticOrder, true, true>(lds, g, S, E);
#endif
        }
        GRID_SYNC();
#ifdef PROBE_P2
        {   attn_phase(kp, lds, G, true);
            constexpr int N_SGU = 256, N_CONV = 1024;
            for (int it = bid; it < N_SGU + N_CONV; it += G) {
                if (it < N_SGU) sgu_unit(kp, l, it, lds, true);
                if (it >= N_SGU) conv_unit(kp, l, it - N_SGU);
            }
        }
        GRID_SYNC();
#endif
#ifdef PROBE_SGU
        for (int it = bid; it < 256; it += G) sgu_unit(kp, l, it, lds, true);
        GRID_SYNC();
#endif
#ifdef PROBE_CONV
        for (int it = bid; it < 1024; it += G) conv_unit(kp, l, it);
        GRID_SYNC();
#endif
#ifdef PROBE_ATT
        attn_phase(kp, lds, G, true);
        GRID_SYNC();
#endif
        {
#ifndef NO_ATT
            attn_phase(kp, lds, G);
#endif
            constexpr int N_SGU = 256, N_CONV = 1024;
            for (int it = bid; it < N_SGU + N_CONV; it += G) {
#ifndef NO_SGU
                if (it < N_SGU) sgu_unit(kp, l, it, lds);
#endif
#ifndef NO_CONV
                if (it >= N_SGU) conv_unit(kp, l, it - N_SGU);
#endif
            }
        }
        GRID_SYNC();
#ifdef PROBE_ML
        for (int it = bid; it < 256; it += G) mlstm_unit(kp, l, it, lds, true);
        GRID_SYNC();
#endif
#ifndef NO_ML
        for (int it = bid; it < 256; it += G) mlstm_unit(kp, l, it, lds);
#endif
        GRID_SYNC();
#ifndef NO_FIN
        finish_phase(kp, l, G);
#endif
#ifdef PROBE_FIN
        GRID_SYNC(); finish_phase(kp, l, G);
#endif
        GRID_SYNC();
        {
            const Args A = load_args(kp);
            pg8::Gemm g{(const pg8::bf16_t*)(A.ws + WS_XB), (const pg8::bf16_t*)(A.ws + WS_WOUT + l * WOUT_BYTES), M, D, D};
            pg8::StaticOrder S; S.init(M, D, G, bid);
            pg8::EpiBf16<0> E{(pg8::bf16_t*)(A.ws + WS_Z), D, nullptr, 0, 0, 1.f};
#ifndef NO_G2
            pg8::gemm_phase<pg8::EpiBf16<0>, pg8::StaticOrder, true, true>(lds, g, S, E);
#endif
#ifdef PROBE_G2
            if (l == 0) { GRID_SYNC(); pg8::gemm_phase<pg8::EpiBf16<0>, pg8::StaticOrder, true, true>(lds, g, S, E); }
#endif
        }
        GRID_SYNC();
#ifdef PROBE_SYNC
        for (int i = 0; i < 10; ++i) GRID_SYNC();
#endif
#ifndef NO_LN
        ln_phase(kp, l, G, lds);
#endif
        if (l + 1 < DEPTH) GRID_SYNC();
    }
}

extern "C" void kernel_launch(void* const* d_in, const int* in_sizes, int n_in, void* d_out, int out_size, void* d_ws, size_t ws_size, hipStream_t stream) {
    static int grid = 0;
    if (grid == 0) {
        if (n_in != 15 || out_size != M * D || ws_size < WS_END) { fprintf(stderr, "kernel_launch: unexpected shapes (n_in %d out %d ws %zu need %zu)\n", n_in, out_size, ws_size, (size_t)WS_END); grid = -1; return; }
        int dev = 0, cus = 0, per_cu = 0;
        (void)hipGetDevice(&dev);
        (void)hipDeviceGetAttribute(&cus, hipDeviceAttributeMultiprocessorCount, dev);
        (void)hipFuncSetAttribute((const void*)fwd_megakernel, hipFuncAttributeMaxDynamicSharedMemorySize, LDS_BYTES);
        (void)hipOccupancyMaxActiveBlocksPerMultiprocessor(&per_cu, (const void*)fwd_megakernel, 512, LDS_BYTES);
        if (per_cu < 1) per_cu = 1;
        grid = cus * per_cu;
    }
    if (grid < 0) return;
    Args a{};
    a.x = (const float*)d_in[0]; a.pos = (const int*)d_in[1]; a.w_in = (const float*)d_in[2]; a.sgu_ln_g = (const float*)d_in[3]; a.sgu_ln_b = (const float*)d_in[4];
    a.w_spatial = (const float*)d_in[5]; a.b_spatial = (const float*)d_in[6]; a.conv_w = (const float*)d_in[7]; a.conv_b = (const float*)d_in[8];
    a.b_igate = (const float*)d_in[9]; a.b_fgate = (const float*)d_in[10]; a.head_norm_g = (const float*)d_in[11]; a.w_out = (const float*)d_in[12];
    a.ln_g = (const float*)d_in[13]; a.ln_b = (const float*)d_in[14]; a.out = (float*)d_out; a.ws = (unsigned char*)d_ws;
    (void)hipMemsetAsync((unsigned char*)d_ws + WS_BAR, 0, XCD_BAR_WORDS * 4, stream);
    void* args[] = {&a};
    hipError_t e = hipLaunchCooperativeKernel((void*)fwd_megakernel, dim3(grid), dim3(512), args, LDS_BYTES, stream);
    if (e != hipSuccess) fprintf(stderr, "cooperative launch failed: %s (grid %d)\n", hipGetErrorString(e), grid);
}
```
